# Optimizing an MI355X kernel written in HIP

```python
import jax, jax.numpy as jnp
from jax import lax
import numpy as np

D_MODEL = 1024
BATCH = 8
SEQ = 4096
DEPTH = 2

HEAD_DIM = 64
SB_WIDTH = D_MODEL // 2
SB_HEADS = SB_WIDTH // HEAD_DIM
LRU_WIDTH = D_MODEL // 4
LRU_BLOCKS = LRU_WIDTH // HEAD_DIM
XA_WIDTH = D_MODEL // 4
XA_HEADS = XA_WIDTH // HEAD_DIM
D_MIX = SB_WIDTH + LRU_WIDTH + XA_WIDTH
N_MEM = 256
CONV_WIDTH = 4
LRU_C = 8.0
Q_BLOCK = 128
EPS = 1e-6
IN_SPLITS = (SB_WIDTH, SB_WIDTH, SB_WIDTH, SB_WIDTH, LRU_WIDTH, LRU_WIDTH, XA_WIDTH, XA_WIDTH)
D_IN = 4 * SB_WIDTH + 2 * LRU_WIDTH + 2 * XA_WIDTH

kernel_name = 'hymba_style_stickbreak_rglru_memxattn'


def rmsnorm(x, g):
    xf = x.astype(jnp.float32)
    y = xf * lax.rsqrt(jnp.mean(xf * xf, axis=-1, keepdims=True) + EPS)
    return (y * g.astype(jnp.float32)).astype(x.dtype)


def stick_breaking_attention(q, k, v):
    S = q.shape[2]
    scale = HEAD_DIM ** -0.5
    qf, kf, vf = q.astype(jnp.float32), k.astype(jnp.float32), v.astype(jnp.float32)
    outs = []
    for start in range(0, S, Q_BLOCK):
        end = start + Q_BLOCK
        z = jnp.einsum('bhqd,bhkd->bhqk', qf[:, :, start:end], kf[:, :, :end]) * scale
        t_idx = start + jnp.arange(Q_BLOCK)[:, None]
        s_idx = jnp.arange(end)[None, :]
        mask = s_idx < t_idx
        log_fail = jnp.where(mask, -jax.nn.softplus(z), 0.0)
        suffix = lax.cumsum(log_fail, axis=log_fail.ndim - 1, reverse=True)
        later = jnp.pad(suffix[..., 1:], ((0, 0), (0, 0), (0, 0), (0, 1)))
        w = jnp.where(mask, jnp.exp(jax.nn.log_sigmoid(z) + later), 0.0)
        outs.append(jnp.einsum('bhqk,bhkd->bhqd', w, vf[:, :, :end]))
    return jnp.concatenate(outs, axis=2).astype(v.dtype)


def causal_depthwise_conv(x, w, b):
    C = x.shape[-1]
    y = lax.conv_general_dilated(x, w[:, None, :].astype(x.dtype), window_strides=(1,),
                                 padding=[(CONV_WIDTH - 1, 0)],
                                 dimension_numbers=('NWC', 'WIO', 'NWC'),
                                 feature_group_count=C)
    return y + b.astype(x.dtype)


def rg_lru(xc, w_rg, b_rg, w_ig, b_ig, lam):
    B, S, W = xc.shape
    xf = xc.astype(jnp.float32)
    xb = xf.reshape(B, S, LRU_BLOCKS, HEAD_DIM)
    r = jax.nn.sigmoid(jnp.einsum('bsnd,nde->bsne', xb, w_rg.astype(jnp.float32)).reshape(B, S, W)
                       + b_rg.astype(jnp.float32))
    i = jax.nn.sigmoid(jnp.einsum('bsnd,nde->bsne', xb, w_ig.astype(jnp.float32)).reshape(B, S, W)
                       + b_ig.astype(jnp.float32))
    log_a = -LRU_C * r * jax.nn.softplus(-lam.astype(jnp.float32))
    a = jnp.exp(log_a)
    u = jnp.sqrt(-jnp.expm1(2.0 * log_a)) * (i * xf)

    def combine(left, right):
        a_l, b_l = left
        a_r, b_r = right
        return a_l * a_r, a_r * b_l + b_r

    _, h = lax.associative_scan(combine, (a, u), axis=1)
    return h.astype(xc.dtype)


def memory_cross_attention(xq, mem, mem_g, w_mem_kv, q_g, k_g):
    B, S, _ = xq.shape
    M = mem.shape[1]
    kv = rmsnorm(mem, mem_g) @ w_mem_kv
    mk, mv = jnp.split(kv, 2, axis=-1)
    mk = rmsnorm(mk.reshape(B, M, XA_HEADS, HEAD_DIM), k_g)
    mv = mv.reshape(B, M, XA_HEADS, HEAD_DIM)
    q = rmsnorm(xq.reshape(B, S, XA_HEADS, HEAD_DIM), q_g)
    scores = jnp.einsum('bshd,bmhd->bhsm', q.astype(jnp.float32), mk.astype(jnp.float32)) * (HEAD_DIM ** -0.5)
    p = jax.nn.softmax(scores, axis=-1)
    o = jnp.einsum('bhsm,bmhd->bshd', p, mv.astype(jnp.float32))
    return o.reshape(B, S, XA_WIDTH).astype(xq.dtype)


def hybrid_layer(x, mem, norm_g, w_in, sb_q_g, sb_k_g, conv_w, conv_b, w_rg, b_rg, w_ig, b_ig,
                 lru_lambda, xa_q_g, xa_k_g, mem_g, w_mem_kv, w_out):
    B, S, _ = x.shape
    h = rmsnorm(x, norm_g)
    proj = h @ w_in
    sb_q, sb_k, sb_v, sb_gate, lru_x, lru_gate, xa_q, xa_gate = jnp.split(
        proj, [int(c) for c in np.cumsum(IN_SPLITS)[:-1]], axis=-1)

    def to_heads(t, n):
        return t.reshape(B, S, n, HEAD_DIM).transpose(0, 2, 1, 3)

    q = rmsnorm(to_heads(sb_q, SB_HEADS), sb_q_g)
    k = rmsnorm(to_heads(sb_k, SB_HEADS), sb_k_g)
    v = to_heads(sb_v, SB_HEADS)
    sb_out = stick_breaking_attention(q, k, v).transpose(0, 2, 1, 3).reshape(B, S, SB_WIDTH)

    xc = causal_depthwise_conv(lru_x, conv_w, conv_b)
    lru_out = rg_lru(xc, w_rg, b_rg, w_ig, b_ig, lru_lambda)

    xa_out = memory_cross_attention(xa_q, mem, mem_g, w_mem_kv, xa_q_g, xa_k_g)

    y = jnp.concatenate([sb_out * jax.nn.silu(sb_gate),
                         lru_out * jax.nn.silu(lru_gate),
                         xa_out * jax.nn.silu(xa_gate)], axis=-1)
    return x + (y @ w_out).astype(x.dtype)


def setup_inputs(seed: int = 0) -> dict:
    key = jax.random.key(seed)
    ks = jax.random.split(key, 20)
    f32 = jnp.float32

    def gain(k, shape):
        return 1.0 + 0.02 * jax.random.normal(k, shape, f32)

    u = jax.random.uniform(ks[12], (DEPTH, LRU_WIDTH), f32, minval=0.9, maxval=0.999)
    a0 = u ** (1.0 / LRU_C)
    return {
        'x': jax.random.normal(ks[0], (BATCH, SEQ, D_MODEL), f32),
        'mem': jax.random.normal(ks[1], (BATCH, N_MEM, D_MODEL), f32),
        'norm_g': gain(ks[2], (DEPTH, D_MODEL)),
        'w_in': jax.random.normal(ks[3], (DEPTH, D_MODEL, D_IN), f32) * D_MODEL ** -0.5,
        'sb_q_g': gain(ks[4], (DEPTH, HEAD_DIM)),
        'sb_k_g': gain(ks[5], (DEPTH, HEAD_DIM)),
        'conv_w': jax.random.normal(ks[6], (DEPTH, CONV_WIDTH, LRU_WIDTH), f32) * CONV_WIDTH ** -0.5,
        'conv_b': 0.01 * jax.random.normal(ks[7], (DEPTH, LRU_WIDTH), f32),
        'w_rg': jax.random.normal(ks[8], (DEPTH, LRU_BLOCKS, HEAD_DIM, HEAD_DIM), f32) * HEAD_DIM ** -0.5,
        'b_rg': 0.01 * jax.random.normal(ks[9], (DEPTH, LRU_WIDTH), f32),
        'w_ig': jax.random.normal(ks[10], (DEPTH, LRU_BLOCKS, HEAD_DIM, HEAD_DIM), f32) * HEAD_DIM ** -0.5,
        'b_ig': 0.01 * jax.random.normal(ks[11], (DEPTH, LRU_WIDTH), f32),
        'lru_lambda': jnp.log(a0) - jnp.log1p(-a0),
        'xa_q_g': gain(ks[13], (DEPTH, HEAD_DIM)),
        'xa_k_g': gain(ks[14], (DEPTH, HEAD_DIM)),
        'mem_g': gain(ks[15], (DEPTH, D_MODEL)),
        'w_mem_kv': jax.random.normal(ks[16], (DEPTH, D_MODEL, 2 * XA_WIDTH), f32) * D_MODEL ** -0.5,
        'w_out': jax.random.normal(ks[17], (DEPTH, D_MIX, D_MODEL), f32) * D_MIX ** -0.5,
    }


def reference(x, mem, norm_g, w_in, sb_q_g, sb_k_g, conv_w, conv_b, w_rg, b_rg, w_ig, b_ig,
              lru_lambda, xa_q_g, xa_k_g, mem_g, w_mem_kv, w_out):
    for l in range(DEPTH):
        x = hybrid_layer(x, mem, norm_g[l], w_in[l], sb_q_g[l], sb_k_g[l], conv_w[l], conv_b[l],
                         w_rg[l], b_rg[l], w_ig[l], b_ig[l], lru_lambda[l], xa_q_g[l], xa_k_g[l],
                         mem_g[l], w_mem_kv[l], w_out[l])
    return x
```

```cpp
#include <hip/hip_runtime.h>
#include <hip/hip_cooperative_groups.h>
#include <cstdio>
#include <cstdint>
namespace cg = cooperative_groups;
namespace pg8 {
#define PG8_LAS __attribute__((address_space(3)))
typedef unsigned short bf16_t;
typedef short bf16x8 __attribute__((ext_vector_type(8)));
typedef float f32x4 __attribute__((ext_vector_type(4)));
typedef unsigned u32x4 __attribute__((ext_vector_type(4)));
constexpr int BM = 256, BK = 64, HALF = 128, HTB = HALF * BK * 2  , STAGE_BYTES = 8 * HTB, NXCD = 8, WGM = 8;

__host__ __device__ __forceinline__ int lds_byte(int r, int c) { const int st = (r >> 4) * 2 + (c >> 5), rr = r & 15, cc = c & 31, ob = rr * 64 + cc * 2; return st * 1024 + (ob ^ (((ob >> 9) & 1) << 5)); }
__host__ __device__ __forceinline__ void stage_rc(int b, int& R, int& C) { const int st = b / 1024, sb = b % 1024, swz = sb ^ (((sb >> 9) & 1) << 5); R = (st >> 1) * 16 + swz / 64; C = (st & 1) * 32 + (swz % 64) / 2; }
__host__ __device__ __forceinline__ int perm32(int rho) { const int n = rho >> 4, i = rho & 15; return 8 * (i >> 2) + 4 * n + (i & 3); }

struct Unit { int pm, pn; };
struct Gemm { const bf16_t* A; const bf16_t* Bt; int M, N, K; };

struct StaticOrder {
    int nM, nN, nwg, G, c;
    __host__ __device__ void init(int M, int N, int G_, int c_) { nM = M / BM; nN = N / BM; nwg = nM * nN; G = G_; c = c_; }
    __host__ __device__ bool next(int i, Unit& u) const {
        const long L = (long)i * G + c; if (L >= nwg) return false;
        int wgid = (int)L; { const int q = nwg / NXCD, r = nwg % NXCD, xcd = wgid % NXCD, off = wgid / NXCD; wgid = (xcd < r ? xcd * (q + 1) : r * (q + 1) + (xcd - r) * q) + off; }
        const int nig = WGM * nN, gid = wgid / nig, fm = gid * WGM, gsz = (nM - fm) < WGM ? (nM - fm) : WGM;
        u.pm = fm + ((wgid % nig) % gsz); u.pn = (wgid % nig) / gsz; return true;
    }
    __device__ __forceinline__ void a_ready(const Unit&) const {}
    __device__ __forceinline__ void done(const Unit&) const {}
};
__device__ __forceinline__ unsigned cvt_pk_bf16(float lo, float hi) { unsigned r; asm volatile("v_cvt_pk_bf16_f32 %0, %1, %2" : "=v"(r) : "v"(lo), "v"(hi)); return r; }
typedef float f32x2 __attribute__((ext_vector_type(2)));
template <class Epi, class Sched, bool ALIGN_EPI = false, bool SP2 = false>
__device__ __forceinline__ void gemm_phase(PG8_LAS unsigned char* lds, const Gemm g, const Sched& S, const Epi& E) {
    int tid_ = threadIdx.x; asm volatile("" : "+v"(tid_));
    const int tid = tid_, wid = __builtin_amdgcn_readfirstlane(tid >> 6), lane = tid & 63, wr = wid >> 2, wc = wid & 3, fr = lane & 15, fq = lane >> 4;
    const int K = g.K, nt = K / BK;
    unsigned voffA[2], voffB[2];
#pragma unroll
    for (int i = 0; i < 2; ++i) { int R, C; stage_rc(tid * 16 + i * 8192, R, C); const int Rb = Epi::PERM ? ((R & ~31) + perm32(R & 31)) : R;
        voffA[i] = (unsigned)(R * K + C) * 2u; voffB[i] = (unsigned)(Rb * K + C) * 2u; }
    const size_t kstep = (size_t)(BK * 2);
    const size_t hstep = (size_t)HALF * K * 2;
    const size_t tstep = 2 * hstep;
    const unsigned ldsw = (unsigned)wid * 1024u;
    const int aoff = lds_byte(wr * 64 + fr, fq * 8), boff = lds_byte(wc * 32 + fr, fq * 8);
#define PG8_SA(b, h) (((b) * 2 + (h)) * HTB)
#define PG8_SB(b, h) ((4 + (b) * 2 + (h)) * HTB)
#define PG8_STAGE(bufoff, gbase, voff) do { _Pragma("unroll") for (int _i = 0; _i < 2; ++_i) \
        __builtin_amdgcn_global_load_lds((const unsigned*)((const char*)(gbase) + (voff)[_i]), (PG8_LAS unsigned*)(lds + (bufoff) + ldsw + _i * 8192), 16, 0, 0); } while (0)
#define PG8_LDA(dst, b, h) do { _Pragma("unroll") for (int m = 0; m < 4; ++m) _Pragma("unroll") for (int k = 0; k < 2; ++k) dst[m][k] = *(const PG8_LAS bf16x8*)(lds + PG8_SA(b, h) + aoff + m * 2048 + k * 1024); } while (0)
#define PG8_LDB(dst, b, h) do { _Pragma("unroll") for (int n = 0; n < 2; ++n) _Pragma("unroll") for (int k = 0; k < 2; ++k) dst[n][k] = *(const PG8_LAS bf16x8*)(lds + PG8_SB(b, h) + boff + n * 2048 + k * 1024); } while (0)
#define PG8_MMA(ai, bj, At, Bt) do { __builtin_amdgcn_s_setprio(1); _Pragma("unroll") for (int m = 0; m < 4; ++m) _Pragma("unroll") for (int n = 0; n < 2; ++n) _Pragma("unroll") for (int k = 0; k < 2; ++k) \
        acc[ai][bj][m][n] = __builtin_amdgcn_mfma_f32_16x16x32_bf16(Bt[n][k], At[m][k], acc[ai][bj][m][n], 0, 0, 0); __builtin_amdgcn_s_setprio(0); } while (0)
#define PG8_WAIT_V(n) asm volatile("s_waitcnt vmcnt(" #n ")" ::: "memory")
#define PG8_WAIT_L(n) asm volatile("s_waitcnt lgkmcnt(" #n ")" ::: "memory")
#define PG8_BAR __builtin_amdgcn_s_barrier()
#define PG8_SCHED __builtin_amdgcn_sched_barrier(0)
    Unit cur, nxt; int ui = 0;
    if (!S.next(0, cur)) return;
    f32x4 acc[2][2][4][2];
#pragma unroll
    for (int a = 0; a < 2; ++a)
#pragma unroll
        for (int b = 0; b < 2; ++b)
#pragma unroll
            for (int m = 0; m < 4; ++m)
#pragma unroll
                for (int n = 0; n < 2; ++n) acc[a][b][m][n] = (f32x4){0.f, 0.f, 0.f, 0.f};
    bf16x8 At[4][2], B0[2][2], B1[2][2];
    const char* cA = (const char*)g.A + (size_t)cur.pm * tstep; const char* cB = (const char*)g.Bt + (size_t)cur.pn * tstep;
    S.a_ready(cur);
    if constexpr (SP2) {
        PG8_STAGE(PG8_SB(0, 0), cB, voffB); PG8_STAGE(PG8_SB(0, 1), cB + hstep, voffB); PG8_STAGE(PG8_SA(0, 0), cA, voffA); PG8_STAGE(PG8_SA(0, 1), cA + hstep, voffA);
        if (wr == 1) PG8_BAR;
        PG8_WAIT_V(2); PG8_BAR;
        PG8_STAGE(PG8_SB(1, 0), cB + kstep, voffB); PG8_STAGE(PG8_SA(1, 0), cA + kstep, voffA); PG8_STAGE(PG8_SB(1, 1), cB + hstep + kstep, voffB);
        PG8_WAIT_V(6); PG8_BAR;
    } else {
        PG8_STAGE(PG8_SB(0, 0), cB, voffB); PG8_STAGE(PG8_SA(0, 0), cA, voffA); PG8_STAGE(PG8_SB(0, 1), cB + hstep, voffB); PG8_STAGE(PG8_SA(0, 1), cA + hstep, voffA);
        if (wr == 1) PG8_BAR;
        PG8_WAIT_V(4); PG8_BAR;
        PG8_STAGE(PG8_SB(1, 0), cB + kstep, voffB); PG8_STAGE(PG8_SA(1, 0), cA + kstep, voffA); PG8_STAGE(PG8_SB(1, 1), cB + hstep + kstep, voffB);
        PG8_WAIT_V(6); PG8_BAR;
    }
    for (;;) {
        const bool has_next = S.next(ui + 1, nxt);
        const char* nA = has_next ? (const char*)g.A + (size_t)nxt.pm * tstep : cA; const char* nB = has_next ? (const char*)g.Bt + (size_t)nxt.pn * tstep : cB;
        for (int t = 0; t < nt; t += 2) {
            const bool last = (t == nt - 2);
            const char* a1 = cA + (size_t)(t + 1) * kstep;
            const char* a2 = last ? nA : cA + (size_t)(t + 2) * kstep; const char* b2 = last ? nB : cB + (size_t)(t + 2) * kstep;
            const char* a3 = a2 + kstep; const char* b3 = b2 + kstep;
            if (last && has_next) S.a_ready(nxt);
            if constexpr (SP2) {
            PG8_LDB(B0, 0, 0); PG8_LDB(B1, 0, 1); PG8_SCHED; PG8_LDA(At, 0, 0); PG8_STAGE(PG8_SA(1, 1), a1 + hstep, voffA);
            PG8_WAIT_V(8); PG8_WAIT_L(0); PG8_BAR; PG8_MMA(0, 0, At, B0); PG8_MMA(0, 1, At, B1); PG8_BAR; PG8_SCHED;
            PG8_LDA(At, 0, 1); PG8_STAGE(PG8_SB(0, 0), b2, voffB); PG8_STAGE(PG8_SB(0, 1), b2 + hstep, voffB); PG8_STAGE(PG8_SA(0, 0), a2, voffA);
            PG8_WAIT_V(8); PG8_WAIT_L(0); PG8_BAR; PG8_MMA(1, 0, At, B0); PG8_MMA(1, 1, At, B1); PG8_BAR; PG8_SCHED;
            PG8_LDB(B0, 1, 0); PG8_LDB(B1, 1, 1); PG8_SCHED; PG8_LDA(At, 1, 0); PG8_STAGE(PG8_SA(0, 1), a2 + hstep, voffA);
            PG8_WAIT_V(8); PG8_WAIT_L(0); PG8_BAR; PG8_MMA(0, 0, At, B0); PG8_MMA(0, 1, At, B1); PG8_BAR; PG8_SCHED;
            PG8_LDA(At, 1, 1); PG8_STAGE(PG8_SB(1, 0), b3, voffB); PG8_STAGE(PG8_SB(1, 1), b3 + hstep, voffB); PG8_STAGE(PG8_SA(1, 0), a3, voffA);
            PG8_WAIT_V(8); PG8_WAIT_L(0); PG8_BAR; PG8_MMA(1, 0, At, B0); PG8_MMA(1, 1, At, B1); PG8_BAR; PG8_SCHED;
            } else {
            PG8_LDB(B0, 0, 0); PG8_SCHED; PG8_LDA(At, 0, 0); PG8_STAGE(PG8_SA(1, 1), a1 + hstep, voffA);
            PG8_WAIT_L(8); PG8_BAR; PG8_WAIT_L(0); PG8_MMA(0, 0, At, B0); PG8_BAR; PG8_SCHED;
            PG8_LDB(B1, 0, 1); PG8_STAGE(PG8_SB(0, 0), b2, voffB);
            PG8_BAR; PG8_WAIT_L(0); PG8_MMA(0, 1, At, B1); PG8_BAR;
            PG8_LDA(At, 0, 1); PG8_STAGE(PG8_SA(0, 0), a2, voffA);
            PG8_BAR; PG8_WAIT_L(0); PG8_MMA(1, 0, At, B0); PG8_BAR; PG8_SCHED;
            PG8_STAGE(PG8_SB(0, 1), b2 + hstep, voffB);
            PG8_WAIT_V(6); PG8_BAR; PG8_MMA(1, 1, At, B1); PG8_BAR;
            PG8_LDB(B0, 1, 0); PG8_SCHED; PG8_LDA(At, 1, 0); PG8_STAGE(PG8_SA(0, 1), a2 + hstep, voffA);
            PG8_WAIT_L(8); PG8_BAR; PG8_WAIT_L(0); PG8_MMA(0, 0, At, B0); PG8_BAR; PG8_SCHED;
            PG8_LDB(B1, 1, 1); PG8_STAGE(PG8_SB(1, 0), b3, voffB);
            PG8_BAR; PG8_WAIT_L(0); PG8_MMA(0, 1, At, B1); PG8_BAR;
            PG8_LDA(At, 1, 1); PG8_STAGE(PG8_SA(1, 0), a3, voffA);
            PG8_BAR; PG8_WAIT_L(0); PG8_MMA(1, 0, At, B0); PG8_BAR; PG8_SCHED;
            PG8_STAGE(PG8_SB(1, 1), b3 + hstep, voffB);
            PG8_WAIT_V(6); PG8_BAR; PG8_MMA(1, 1, At, B1); PG8_BAR;
            }
        }
        if constexpr (ALIGN_EPI) { if (wr == 0) PG8_BAR; }
        if constexpr (!Epi::AFTER_DRAIN) { E(acc, cur, wr, wc, fr, fq); S.done(cur); }
        if (!has_next) break;
#pragma unroll
        for (int a = 0; a < 2; ++a)
#pragma unroll
            for (int b = 0; b < 2; ++b)
#pragma unroll
                for (int m = 0; m < 4; ++m)
#pragma unroll
                    for (int n = 0; n < 2; ++n) acc[a][b][m][n] = (f32x4){0.f, 0.f, 0.f, 0.f};
        cur = nxt; cA = nA; cB = nB; ++ui;
        if constexpr (ALIGN_EPI) { if (wr == 1) PG8_BAR; }
    }
    PG8_WAIT_V(0);
    if constexpr (!ALIGN_EPI) { if (wr == 0) PG8_BAR; }
    PG8_BAR;
    if constexpr (Epi::AFTER_DRAIN) { E.fused(acc, cur, wr, wc, fr, fq, lds, wid, lane); S.done(cur); }
#undef PG8_SA
#undef PG8_SB
#undef PG8_STAGE
#undef PG8_LDA
#undef PG8_LDB
#undef PG8_MMA
#undef PG8_WAIT_V
#undef PG8_WAIT_L
#undef PG8_BAR
#undef PG8_SCHED
}
}

constexpr int BATCH = 8, SEQ = 4096, DM = 1024, DIN = 3072, NMEM = 256;
constexpr int MTOK = BATCH * SEQ;
constexpr int MMEM = BATCH * NMEM;
constexpr int LRU_W = 256, CHUNK = 64, NCHUNK = SEQ / CHUNK;
constexpr float EPS = 1e-6f, LOG2E = 1.4426950408889634f, LN2 = 0.6931471805599453f;
constexpr int C_SBQ = 0, C_SBK = 512, C_SBV = 1024, C_SBG = 1536, C_LX = 2048, C_LG = 2304, C_XQ = 2560, C_XG = 2816;

constexpr size_t MiB = 1u << 20;
constexpr size_t WS_WIN0 = 0;
constexpr size_t WS_WIN1 = 8 * MiB;
constexpr size_t WS_WOUT = 14 * MiB;
constexpr size_t WS_WG = 18 * MiB;
constexpr size_t WS_SS = 19 * MiB;
constexpr size_t WS_MRS = 21 * MiB;
constexpr size_t WS_PH = 420 * MiB;
constexpr size_t WS_BAR = 23 * MiB;
constexpr size_t WS_KV = 24 * MiB;
constexpr size_t WS_XB = 32 * MiB;
constexpr size_t WS_PROJ = 100 * MiB;
constexpr size_t WS_Y = 292 * MiB;
constexpr size_t WS_END = 424 * MiB;

#define LAS __attribute__((address_space(3)))
typedef unsigned short bf16_t;
typedef short bf16x8 __attribute__((ext_vector_type(8)));
typedef float f32x16 __attribute__((ext_vector_type(16)));
typedef float f32x4 __attribute__((ext_vector_type(4)));
typedef float f32x2 __attribute__((ext_vector_type(2)));
typedef unsigned u32x4 __attribute__((ext_vector_type(4)));
typedef unsigned u32x2 __attribute__((ext_vector_type(2)));
typedef short v4i16_t __attribute__((ext_vector_type(4)));
typedef __bf16 bf16x2_t __attribute__((ext_vector_type(2)));

__device__ __forceinline__ unsigned pk2(float lo, float hi) { f32x2 v = {lo, hi}; bf16x2_t b = __builtin_convertvector(v, bf16x2_t); return __builtin_bit_cast(unsigned, b); }
__device__ __forceinline__ float bflo(unsigned u) { return __uint_as_float(u << 16); }
__device__ __forceinline__ float bfhi(unsigned u) { return __uint_as_float(u & 0xffff0000u); }
__device__ __forceinline__ float ex2(float x) { return __builtin_amdgcn_exp2f(x); }
__device__ __forceinline__ float lg2(float x) { return __builtin_amdgcn_logf(x); }
__device__ __forceinline__ float silu(float g) { return g * __builtin_amdgcn_rcpf(1.f + ex2(-g * LOG2E)); }
__device__ __forceinline__ float sigm(float g) { return __builtin_amdgcn_rcpf(1.f + ex2(-g * LOG2E)); }
__device__ __forceinline__ int crow(int r, int hi) { return (r & 3) + 8 * (r >> 2) + 4 * hi; }

constexpr float QSCALE = 0.125f * 1.4426950408889634f;
__host__ __device__ __forceinline__ int phys_col(int c) { return (c & ~0xE0) | (((c >> 5) & 1) << 7) | (((c >> 6) & 3) << 5); }
struct EpiProj {
    static constexpr bool PERM = true, AFTER_DRAIN = false;
    bf16_t* proj; bf16_t* kvmem; const float* sspart; const float* memrstd; const float* qg; const float* kg; const float* xqg; const float* xkg2;
    __device__ __forceinline__ void operator()(const pg8::f32x4 (&acc)[2][2][4][2], const pg8::Unit& u, int wr, int wc, int fr, int fq) const {
        const bool ismem = u.pm >= 128;
        const float* gp = nullptr; float nscale = 1.f;
        if (!ismem) { if (u.pn < 2) { gp = qg; nscale = QSCALE; } else if (u.pn < 4) gp = kg; else if (u.pn == 10) { gp = xqg; nscale = QSCALE; } }
        else { const int t = u.pn - 12; if ((t & 1) == 0) gp = xkg2 + (t >> 1) * 64; }
        const bool isgate = !ismem && (u.pn == 6 || u.pn == 7 || u.pn == 9 || u.pn == 11);
        f32x4 gv[2][2];
#pragma unroll
        for (int bj = 0; bj < 2; ++bj)
#pragma unroll
            for (int n = 0; n < 2; ++n) gv[bj][n] = gp ? *(const f32x4*)(gp + 32 * bj + 8 * fq + 4 * n) : (f32x4){1.f, 1.f, 1.f, 1.f};
        float rsv[2][4];
        if (!ismem) {
            f32x4 pv[2][4];
#pragma unroll
            for (int ai = 0; ai < 2; ++ai)
#pragma unroll
                for (int m = 0; m < 4; ++m) pv[ai][m] = *(const f32x4*)(sspart + (size_t)(u.pm * 256 + ai * 128 + wr * 64 + m * 16 + fr) * 16 + 4 * fq);
#pragma unroll
            for (int ai = 0; ai < 2; ++ai)
#pragma unroll
                for (int m = 0; m < 4; ++m) { float ss = (pv[ai][m].x + pv[ai][m].y) + (pv[ai][m].z + pv[ai][m].w); ss += __shfl_xor(ss, 16); ss += __shfl_xor(ss, 32); rsv[ai][m] = rsqrtf(ss * (1.f / 1024.f) + EPS); }
        } else {
#pragma unroll
            for (int ai = 0; ai < 2; ++ai)
#pragma unroll
                for (int m = 0; m < 4; ++m) rsv[ai][m] = memrstd[u.pm * 256 + ai * 128 + wr * 64 + m * 16 + fr - MTOK];
        }
#pragma unroll
        for (int ai = 0; ai < 2; ++ai)
#pragma unroll
            for (int m = 0; m < 4; ++m) {
                const int row = u.pm * 256 + ai * 128 + wr * 64 + m * 16 + fr;
                const float rs = rsv[ai][m]; bf16_t* rowp;
                if (!ismem) {
                    rowp = proj + (size_t)row * DIN + u.pn * 256 + wc * 64 + 8 * fq;
                } else {
                    const int mr = row - MTOK, t = u.pn - 12;
                    rowp = kvmem + (size_t)(t >> 1) * (MMEM * 512) + (size_t)mr * 512 + (t & 1) * 256 + wc * 64 + 8 * fq;
                }
                pg8::f32x4 v[2][2];
#pragma unroll
                for (int bj = 0; bj < 2; ++bj)
#pragma unroll
                    for (int n = 0; n < 2; ++n) v[bj][n] = acc[ai][bj][m][n] * rs;
                if (isgate) {
#pragma unroll
                    for (int bj = 0; bj < 2; ++bj)
#pragma unroll
                        for (int n = 0; n < 2; ++n) { v[bj][n][0] = silu(v[bj][n][0]); v[bj][n][1] = silu(v[bj][n][1]); v[bj][n][2] = silu(v[bj][n][2]); v[bj][n][3] = silu(v[bj][n][3]); }
                }
                if (gp) {
                    float ss = 0.f;
#pragma unroll
                    for (int bj = 0; bj < 2; ++bj)
#pragma unroll
                        for (int n = 0; n < 2; ++n) ss += (v[bj][n][0] * v[bj][n][0] + v[bj][n][1] * v[bj][n][1]) + (v[bj][n][2] * v[bj][n][2] + v[bj][n][3] * v[bj][n][3]);
                    ss += __shfl_xor(ss, 16); ss += __shfl_xor(ss, 32);
                    const float rn = rsqrtf(ss * (1.f / 64.f) + EPS) * nscale;
#pragma unroll
                    for (int bj = 0; bj < 2; ++bj)
#pragma unroll
                        for (int n = 0; n < 2; ++n) v[bj][n] = v[bj][n] * rn * gv[bj][n];
                }
#pragma unroll
                for (int bj = 0; bj < 2; ++bj) {
                    u32x4 w; w.x = pk2(v[bj][0][0], v[bj][0][1]); w.y = pk2(v[bj][0][2], v[bj][0][3]); w.z = pk2(v[bj][1][0], v[bj][1][1]); w.w = pk2(v[bj][1][2], v[bj][1][3]);
                    *(u32x4*)(rowp + bj * 32) = w;
                }
            }
    }
};
struct EpiOut {
    static constexpr bool PERM = false, AFTER_DRAIN = false;
    const float* xin; const bf16_t* xinb; float* xout; bf16_t* xb; float* sspart;
    __device__ __forceinline__ void operator()(const pg8::f32x4 (&acc)[2][2][4][2], const pg8::Unit& u, int wr, int wc, int fr, int fq) const {
        const int col0 = u.pn * 256 + wc * 32 + 4 * fq;
#pragma unroll
        for (int ai = 0; ai < 2; ++ai) {
            if (xb) {
                f32x4 rf[4][2][2];
#pragma unroll
                for (int m = 0; m < 4; ++m)
#pragma unroll
                    for (int bj = 0; bj < 2; ++bj)
#pragma unroll
                        for (int n = 0; n < 2; ++n) rf[m][bj][n] = *(const f32x4*)(xin + (size_t)(u.pm * 256 + ai * 128 + wr * 64 + m * 16 + fr) * DM + col0 + bj * 128 + n * 16);
#pragma unroll
                for (int m = 0; m < 4; ++m) {
                    const int row = u.pm * 256 + ai * 128 + wr * 64 + m * 16 + fr;
                    const size_t off = (size_t)row * DM + col0;
                    float ss = 0.f;
#pragma unroll
                    for (int bj = 0; bj < 2; ++bj)
#pragma unroll
                        for (int n = 0; n < 2; ++n) {
                            const f32x4 o = rf[m][bj][n] + acc[ai][bj][m][n];
                            ss += (o.x * o.x + o.y * o.y) + (o.z * o.z + o.w * o.w);
                            u32x2 w; w.x = pk2(o.x, o.y); w.y = pk2(o.z, o.w);
                            *(u32x2*)(xb + off + bj * 128 + n * 16) = w;
                        }
                    ss += __shfl_xor(ss, 16); ss += __shfl_xor(ss, 32); if (fq == 0) sspart[(size_t)row * 16 + u.pn * 4 + wc] = ss;
                }
            } else {
                u32x2 rb[4][2][2];
#pragma unroll
                for (int m = 0; m < 4; ++m)
#pragma unroll
                    for (int bj = 0; bj < 2; ++bj)
#pragma unroll
                        for (int n = 0; n < 2; ++n) rb[m][bj][n] = *(const u32x2*)(xinb + (size_t)(u.pm * 256 + ai * 128 + wr * 64 + m * 16 + fr) * DM + col0 + bj * 128 + n * 16);
#pragma unroll
                for (int m = 0; m < 4; ++m) {
                    const size_t off = (size_t)(u.pm * 256 + ai * 128 + wr * 64 + m * 16 + fr) * DM + col0;
#pragma unroll
                    for (int bj = 0; bj < 2; ++bj)
#pragma unroll
                        for (int n = 0; n < 2; ++n) {
                            const u32x2 r2 = rb[m][bj][n];
                            const f32x4 bs = (f32x4){bflo(r2.x), bfhi(r2.x), bflo(r2.y), bfhi(r2.y)};
                            *(f32x4*)(xout + off + bj * 128 + n * 16) = bs + acc[ai][bj][m][n];
                        }
                }
            }
        }
    }
};
struct ProjOrder {
    pg8::StaticOrder so; int extra;
    __device__ void init(int G, int c, int extra_) { so.init(MTOK, DIN, G, c); extra = extra_; }
    __device__ bool next(int i, pg8::Unit& u) const {
        const long L = (long)i * so.G + so.c;
        if (L < so.nwg) return so.next(i, u);
        const int e = (int)(L - so.nwg); if (e >= extra) return false;
        u.pm = 128 + (e & 7); u.pn = 12 + (e >> 3); return true;
    }
    __device__ __forceinline__ void a_ready(const pg8::Unit&) const {}
    __device__ __forceinline__ void done(const pg8::Unit&) const {}
};

__device__ __forceinline__ float wave_sum(float v) {
#pragma unroll
    for (int o = 1; o < 64; o <<= 1) v += __shfl_xor(v, o);
    return v;
}
__device__ __forceinline__ void p0_transpose_item(const float* W, int K, int N, bf16_t* WT, int row_off, const float* gk, bool perm, LAS float* scr, int item, int lane) {
    const int nblk = N / 64, kb = item / nblk, nb = item % nblk, k0 = 64 * kb, n0 = 64 * nb;
    float v[64];
#pragma unroll
    for (int kk = 0; kk < 64; ++kk) v[kk] = W[(size_t)(k0 + kk) * N + n0 + lane];
    if (gk) {
        const float g = gk[k0 + lane];
#pragma unroll
        for (int kk = 0; kk < 64; ++kk) v[kk] *= __shfl(g, kk);
    }
#pragma unroll
    for (int kk = 0; kk < 64; ++kk) scr[kk * 65 + lane] = v[kk];
    asm volatile("s_waitcnt lgkmcnt(0)" ::: "memory");
    const int c = lane & 7;
#pragma unroll
    for (int j = 0; j < 8; ++j) { const int n = (lane >> 3) + 8 * j; const LAS float* s = scr + (8 * c) * 65 + n;
        u32x4 o; o.x = pk2(s[0 * 65], s[1 * 65]); o.y = pk2(s[2 * 65], s[3 * 65]); o.z = pk2(s[4 * 65], s[5 * 65]); o.w = pk2(s[6 * 65], s[7 * 65]);
        *(u32x4*)(WT + (size_t)(row_off + (perm ? phys_col(n0 + n) : n0 + n)) * K + k0 + 8 * c) = o; }
    asm volatile("s_waitcnt lgkmcnt(0)" ::: "memory");
}

__device__ __forceinline__ void ld_frag(const bf16_t* p, bf16x8 (&f)[4]) {
#pragma unroll
    for (int d0 = 0; d0 < 4; ++d0) f[d0] = *(const bf16x8*)(p + 16 * d0);
}
constexpr int VRS = 144;
constexpr int TILE_B = 32 * VRS;
constexpr int SB_WIN = 13;
constexpr int LDS_KIMG = 0, LDS_VIMG = SB_WIN * TILE_B, LDS_WTILE = 2 * SB_WIN * TILE_B, LDS_MISC = LDS_WTILE + 8 * TILE_B;
__device__ __forceinline__ float xor32(float v, int hi) {
    auto rr = __builtin_amdgcn_permlane32_swap(__float_as_uint(v), __float_as_uint(v), false, false);
    return __uint_as_float(hi ? rr[0] : rr[1]);
}
__device__ __forceinline__ void lds_frag(LAS unsigned char* tile, int lane, bf16x8 (&f)[4]) {
    LAS unsigned char* p = tile + (lane & 31) * VRS + 16 * (lane >> 5);
#pragma unroll
    for (int d0 = 0; d0 < 4; ++d0) f[d0] = *(LAS bf16x8*)(p + 32 * d0);
}
__device__ __forceinline__ void pv_tile(LAS unsigned char* vt, int lane, const bf16x8 (&pw)[2], f32x16 (&o)[2]) {
    const int hi = lane >> 5, q = (lane & 15) >> 2, p = lane & 3;
    LAS unsigned char* tb = vt + (4 * hi + q) * VRS + (16 * ((lane >> 4) & 1) + 4 * p) * 2;
#pragma unroll
    for (int s = 0; s < 2; ++s)
#pragma unroll
        for (int dh = 0; dh < 2; ++dh) {
            LAS unsigned char* a0 = tb + (16 * s) * VRS + 64 * dh;
            const v4i16_t lo = __builtin_amdgcn_ds_read_tr16_b64_v4i16((LAS v4i16_t*)a0);
            const v4i16_t hh = __builtin_amdgcn_ds_read_tr16_b64_v4i16((LAS v4i16_t*)(a0 + 8 * VRS));
            const bf16x8 vf = (bf16x8){lo[0], lo[1], lo[2], lo[3], hh[0], hh[1], hh[2], hh[3]};
            __builtin_amdgcn_s_setprio(1);
            o[dh] = __builtin_amdgcn_mfma_f32_32x32x16_bf16(vf, pw[s], o[dh], 0, 0, 0);
            __builtin_amdgcn_s_setprio(0);
        }
}
__device__ __forceinline__ void stage_kv(const bf16_t* src, size_t ld, int voff, int nrows, LAS unsigned char* lds, int tid) {
    for (int idx = tid; idx < nrows * 8; idx += 512) {
        const int row = idx >> 3, ch = idx & 7;
        const bf16_t* sp = src + (size_t)row * ld + ch * 8;
        const u32x4 kv = *(const u32x4*)sp, vv = *(const u32x4*)(sp + voff);
        *(LAS u32x4*)(lds + LDS_KIMG + row * VRS + ch * 16) = kv;
        *(LAS u32x4*)(lds + LDS_VIMG + row * VRS + ch * 16) = vv;
    }
}
__device__ __forceinline__ void gate_load(const bf16_t* grow  , int hi, u32x2 (&gv)[2][4]) {
#pragma unroll
    for (int dh = 0; dh < 2; ++dh)
#pragma unroll
        for (int g = 0; g < 4; ++g) gv[dh][g] = *(const u32x2*)(grow + 32 * dh + 8 * g + 4 * hi);
}
__device__ __forceinline__ void gate_store(const f32x16 (&o)[2], float rscale, const u32x2 (&gv)[2][4], bf16_t* yrow  , int hi) {
#pragma unroll
    for (int dh = 0; dh < 2; ++dh)
#pragma unroll
        for (int g = 0; g < 4; ++g) {
            const int d = 32 * dh + 8 * g + 4 * hi;
            const u32x2 gg = gv[dh][g];
            const float y0 = o[dh][4 * g + 0] * rscale * bflo(gg.x), y1 = o[dh][4 * g + 1] * rscale * bfhi(gg.x);
            const float y2 = o[dh][4 * g + 2] * rscale * bflo(gg.y), y3 = o[dh][4 * g + 3] * rscale * bfhi(gg.y);
            u32x2 w; w.x = pk2(y0, y1); w.y = pk2(y2, y3);
            *(u32x2*)(yrow + d) = w;
        }
}

__device__ __forceinline__ void sb_deal(int r, int nround, int bi, int& bh, int& QB) {
    const int k = r < nround ? r : 2 + ((bi - 32) >> 5), iv = r < nround ? bi : ((bi - 32) & 31);
    const int x = iv & 7, j = iv >> 3; bh = k * 16 + x * 2 + (j >> 4); QB = 15 - (j & 15);
}
__device__ __forceinline__ f32x16 sb_qk(const bf16x8 (&kc)[4], const bf16x8 (&qf)[4]) {
    f32x16 z;
#pragma unroll
    for (int i = 0; i < 16; ++i) z[i] = 0.f;
    __builtin_amdgcn_s_setprio(1);
#pragma unroll
    for (int d0 = 0; d0 < 4; ++d0) z = __builtin_amdgcn_mfma_f32_32x32x16_bf16(kc[d0], qf[d0], z, 0, 0, 0);
    __builtin_amdgcn_s_setprio(0);
    return z;
}
template <bool DIAG> __device__ __forceinline__ bool sb_post(const f32x16& z, LAS unsigned char* vt, f32x16 (&o)[2], float& Rl, int lane) {
    const int r32 = lane & 31, hi = lane >> 5;
    float be[16], fl[16];
#pragma unroll
    for (int r = 0; r < 16; ++r) {
        const float zc = __builtin_amdgcn_fmed3f(z[r], -100.f, 100.f);
        const float e = ex2(-zc);
        const float rc = __builtin_amdgcn_rcpf(1.f + e);
        const bool valid = !DIAG || (crow(r, hi) < r32);
        be[r] = valid ? rc : 0.f;
        fl[r] = valid ? e * rc : 1.f;
    }
    float gp[4], pg[4];
#pragma unroll
    for (int g = 0; g < 4; ++g) { gp[g] = (fl[4 * g] * fl[4 * g + 1]) * (fl[4 * g + 2] * fl[4 * g + 3]); pg[g] = xor32(gp[g], hi); }
    float acc = Rl; float w[16];
#pragma unroll
    for (int g = 3; g >= 0; --g) {
        const float l3 = hi ? acc : acc * pg[g];
        const float l2 = l3 * fl[4 * g + 3], l1 = l2 * fl[4 * g + 2], l0 = l1 * fl[4 * g + 1];
        w[4 * g + 3] = be[4 * g + 3] * l3; w[4 * g + 2] = be[4 * g + 2] * l2; w[4 * g + 1] = be[4 * g + 1] * l1; w[4 * g + 0] = be[4 * g + 0] * l0;
        acc *= gp[g] * pg[g];
    }
    Rl = acc;
    bf16x8 pw[2];
#pragma unroll
    for (int s = 0; s < 2; ++s) { u32x4 t; t.x = pk2(w[8 * s], w[8 * s + 1]); t.y = pk2(w[8 * s + 2], w[8 * s + 3]); t.z = pk2(w[8 * s + 4], w[8 * s + 5]); t.w = pk2(w[8 * s + 6], w[8 * s + 7]); pw[s] = __builtin_bit_cast(bf16x8, t); }
    pv_tile(vt, lane, pw, o);
    return __all(Rl < 1.17549435e-38f);
}
template <bool DIAG> __device__ __forceinline__ bool sb_step(const bf16x8 (&kc)[4], LAS unsigned char* vt, const bf16x8 (&qf)[4], f32x16 (&o)[2], float& Rl, int lane) {
    const f32x16 z = sb_qk(kc, qf);
    return sb_post<DIAG>(z, vt, o, Rl, lane);
}
__device__ __forceinline__ void sb_issue(int b, int h, int QB, const bf16_t* P, int tid, u32x4 (&pk)[4], u32x4 (&pv)[4]) {
    const bf16_t* src = P + ((size_t)b * SEQ + (size_t)QB * 256) * DIN + C_SBK + h * 64;
#pragma unroll
    for (int i = 0; i < 4; ++i) { const int idx = tid + i * 512; const bf16_t* sp = src + (size_t)(idx >> 3) * DIN + (idx & 7) * 8; pk[i] = *(const u32x4*)sp; pv[i] = *(const u32x4*)(sp + (C_SBV - C_SBK)); }
}
__device__ __forceinline__ void sb_block(int b, int h, int QB, const bf16_t* P, bf16_t* Y, LAS unsigned char* lds, int wave, int lane, int tid, u32x4 (&pk)[4], u32x4 (&pv)[4], bool has_next, int bn, int hn, int QBn) {
    asm volatile("" : "+v"(lane), "+v"(tid));
    const int r32 = lane & 31, hi = lane >> 5;
    const int t_hi = QB * 8 + 7, t_lo = QB * 8;
    const bf16_t* kbase = P + (size_t)b * SEQ * DIN + C_SBK + h * 64;
#pragma unroll
    for (int i = 0; i < 4; ++i) { const int idx = tid + i * 512, row = idx >> 3, ch = idx & 7;
        *(LAS u32x4*)(lds + LDS_KIMG + row * VRS + ch * 16) = pk[i]; *(LAS u32x4*)(lds + LDS_VIMG + row * VRS + ch * 16) = pv[i]; }
    const int qt = QB * 8 + wave;
    const size_t rowq = (size_t)b * SEQ + (size_t)qt * 32;
    bf16x8 qf[4];
    ld_frag(P + (rowq + r32) * DIN + C_SBQ + h * 64 + 8 * hi, qf);
    u32x2 gv[2][4];
    gate_load(P + (rowq + r32) * DIN + C_SBG + h * 64, hi, gv);
    f32x16 o[2];
#pragma unroll
    for (int i = 0; i < 16; ++i) { o[0][i] = 0.f; o[1][i] = 0.f; }
    float Rl = 1.f;
    __syncthreads();
    if (has_next) sb_issue(bn, hn, QBn, P, tid, pk, pv);
    int kt = qt;
    {
        f32x16 zA, zB; bf16x8 kc[4];
        lds_frag(lds + LDS_KIMG + (kt - t_lo) * TILE_B, lane, kc); zA = sb_qk(kc, qf);
        bool hasB = kt - 1 >= t_lo;
        if (hasB) { lds_frag(lds + LDS_KIMG + (kt - 1 - t_lo) * TILE_B, lane, kc); zB = sb_qk(kc, qf); }
        bool done = sb_post<true>(zA, lds + LDS_VIMG + (kt - t_lo) * TILE_B, o, Rl, lane);
        --kt;
        if (done) kt = -1;
        else if (hasB) for (;;) {
            bool hasA = kt - 1 >= t_lo;
            if (hasA) { lds_frag(lds + LDS_KIMG + (kt - 1 - t_lo) * TILE_B, lane, kc); zA = sb_qk(kc, qf); }
            done = sb_post<false>(zB, lds + LDS_VIMG + (kt - t_lo) * TILE_B, o, Rl, lane);
            --kt; if (done) { kt = -1; break; } if (!hasA) break;
            hasB = kt - 1 >= t_lo;
            if (hasB) { lds_frag(lds + LDS_KIMG + (kt - 1 - t_lo) * TILE_B, lane, kc); zB = sb_qk(kc, qf); }
            done = sb_post<false>(zA, lds + LDS_VIMG + (kt - t_lo) * TILE_B, o, Rl, lane);
            --kt; if (done) { kt = -1; break; } if (!hasB) break;
        }
    }
    LAS unsigned char* wt = lds + LDS_WTILE + wave * TILE_B;
    for (; kt >= 0; --kt) {
        const bf16_t* kp = kbase + ((size_t)kt * 32 + r32) * DIN + 8 * hi;
        bf16x8 kc[4], vc[4];
        ld_frag(kp, kc); ld_frag(kp + (C_SBV - C_SBK), vc);
#pragma unroll
        for (int d0 = 0; d0 < 4; ++d0) *(LAS bf16x8*)(wt + r32 * VRS + 32 * d0 + 16 * hi) = vc[d0];
        asm volatile("s_waitcnt lgkmcnt(0)" ::: "memory");
        if (sb_step<false>(kc, wt, qf, o, Rl, lane)) break;
        asm volatile("s_waitcnt lgkmcnt(0)" ::: "memory");
    }
    gate_store(o, 1.f, gv, Y + (rowq + r32) * DM + h * 64, hi);
    __syncthreads();
}

__device__ __forceinline__ void xa_block(int b, int h, int QB, const bf16_t* P, const bf16_t* KV, bf16_t* Y, LAS unsigned char* lds, int wave, int lane, int tid) {
    asm volatile("" : "+v"(lane), "+v"(tid));
    const int r32 = lane & 31, hi = lane >> 5;
    stage_kv(KV + (size_t)b * NMEM * 512 + h * 64, 512, 256, NMEM, lds, tid);
    __syncthreads();
#pragma unroll 1
    for (int j = 0; j < 2; ++j) {
        const size_t rowq = (size_t)b * SEQ + (size_t)QB * 512 + (size_t)(wave * 2 + j) * 32;
        bf16x8 qf[4];
        ld_frag(P + (rowq + r32) * DIN + C_XQ + h * 64 + 8 * hi, qf);
        u32x2 gv[2][4];
        gate_load(P + (rowq + r32) * DIN + C_XG + h * 64, hi, gv);
        f32x16 o[2];
#pragma unroll
        for (int i = 0; i < 16; ++i) { o[0][i] = 0.f; o[1][i] = 0.f; }
        float mrun = -1e30f, lsum = 0.f;
#pragma unroll 2
        for (int kt = 0; kt < NMEM / 32; ++kt) {
            bf16x8 kc[4];
            lds_frag(lds + LDS_KIMG + kt * TILE_B, lane, kc);
            f32x16 s;
#pragma unroll
            for (int i = 0; i < 16; ++i) s[i] = 0.f;
            __builtin_amdgcn_s_setprio(1);
#pragma unroll
            for (int d0 = 0; d0 < 4; ++d0) s = __builtin_amdgcn_mfma_f32_32x32x16_bf16(kc[d0], qf[d0], s, 0, 0, 0);
            __builtin_amdgcn_s_setprio(0);
            float mx = s[0];
#pragma unroll
            for (int r = 1; r < 16; ++r) mx = fmaxf(mx, s[r]);
            mx = fmaxf(mx, xor32(mx, hi));
            if (__any(mx > mrun + 8.f)) {
                const float mnew = fmaxf(mrun, mx), alpha = ex2(mrun - mnew);
                mrun = mnew; lsum *= alpha;
#pragma unroll
                for (int i = 0; i < 16; ++i) { o[0][i] *= alpha; o[1][i] *= alpha; }
            }
            float w[16], ps = 0.f;
#pragma unroll
            for (int r = 0; r < 16; ++r) { w[r] = ex2(s[r] - mrun); ps += w[r]; }
            lsum += ps;
            bf16x8 pw[2];
#pragma unroll
            for (int t2 = 0; t2 < 2; ++t2) { u32x4 t; t.x = pk2(w[8 * t2], w[8 * t2 + 1]); t.y = pk2(w[8 * t2 + 2], w[8 * t2 + 3]); t.z = pk2(w[8 * t2 + 4], w[8 * t2 + 5]); t.w = pk2(w[8 * t2 + 6], w[8 * t2 + 7]); pw[t2] = __builtin_bit_cast(bf16x8, t); }
            pv_tile(lds + LDS_VIMG + kt * TILE_B, lane, pw, o);
        }
        lsum += xor32(lsum, hi);
        gate_store(o, 1.f / lsum, gv, Y + (rowq + r32) * DM + 768 + h * 64, hi);
    }
    __syncthreads();
}

constexpr int XLS = 68;
__device__ __forceinline__ void lru_stage_a(int b, int n, int c, const bf16_t* P, const bf16_t* WG  , const float* conv_w, const float* conv_b,
                                            const float* b_rg, const float* b_ig, const float* lam, float* PH  , LAS unsigned char* wl, int lane,
                                            float (&av)[2][2][16], unsigned (&up)[2][2][8]) {
    asm volatile("" : "+v"(lane));
    LAS float* xl = (LAS float*)wl;
    float brg[2], big[2], cl[2], hc[2], cc[2];
    { const int r32 = lane & 31;
#pragma unroll
      for (int eh = 0; eh < 2; ++eh) {
        const int ch = n * 64 + 32 * eh + r32;
        brg[eh] = b_rg[ch]; big[eh] = b_ig[ch];
        const float nl = -lam[ch];
        const float spn = fmaxf(nl, 0.f) + log1pf(__expf(-fabsf(nl)));
        cl[eh] = -8.f * spn;
        hc[eh] = 0.f; cc[eh] = 1.f;
      } }
#pragma unroll
    for (int tile = 0; tile < CHUNK / 32; ++tile) {
        int ln = lane; asm volatile("" : "+v"(ln));
        const int r32 = ln & 31, hi = ln >> 5;
        const int t0 = c * CHUNK + tile * 32;
        bf16x8 xa[4];
#pragma unroll
        for (int d0 = 0; d0 < 4; ++d0) {
            const int chb = n * 64 + 16 * d0 + 8 * hi;
            float a8[8];
            { const f32x4 b0 = *(const f32x4*)(conv_b + chb), b1 = *(const f32x4*)(conv_b + chb + 4);
              a8[0] = b0.x; a8[1] = b0.y; a8[2] = b0.z; a8[3] = b0.w; a8[4] = b1.x; a8[5] = b1.y; a8[6] = b1.z; a8[7] = b1.w; }
#pragma unroll
            for (int tap = 0; tap < 4; ++tap) {
                const int tt = t0 + r32 - 3 + tap;
                u32x4 xr = (u32x4){0u, 0u, 0u, 0u};
                if (tt >= 0) xr = *(const u32x4*)(P + ((size_t)b * SEQ + tt) * DIN + C_LX + chb);
                const f32x4 w0 = *(const f32x4*)(conv_w + tap * LRU_W + chb), w1 = *(const f32x4*)(conv_w + tap * LRU_W + chb + 4);
                a8[0] += w0.x * bflo(xr.x); a8[1] += w0.y * bfhi(xr.x); a8[2] += w0.z * bflo(xr.y); a8[3] += w0.w * bfhi(xr.y);
                a8[4] += w1.x * bflo(xr.z); a8[5] += w1.y * bfhi(xr.z); a8[6] += w1.z * bflo(xr.w); a8[7] += w1.w * bfhi(xr.w);
            }
            u32x4 t; t.x = pk2(a8[0], a8[1]); t.y = pk2(a8[2], a8[3]); t.z = pk2(a8[4], a8[5]); t.w = pk2(a8[6], a8[7]);
            xa[d0] = __builtin_bit_cast(bf16x8, t);
            *(LAS f32x4*)(xl + r32 * XLS + 16 * d0 + 8 * hi) = (f32x4){a8[0], a8[1], a8[2], a8[3]};
            *(LAS f32x4*)(xl + r32 * XLS + 16 * d0 + 8 * hi + 4) = (f32x4){a8[4], a8[5], a8[6], a8[7]};
        }
        asm volatile("s_waitcnt lgkmcnt(0)" ::: "memory");
#pragma unroll
        for (int eh = 0; eh < 2; ++eh) {
            float uvt[16];
            f32x16 Rg, Ig;
#pragma unroll
            for (int i = 0; i < 16; ++i) { Rg[i] = 0.f; Ig[i] = 0.f; }
            { bf16x8 wr[4], wi[4];
#pragma unroll
              for (int d0 = 0; d0 < 4; ++d0) {
                  wr[d0] = *(const bf16x8*)(WG + ((size_t)(n * 2 + 0) * 64 + 32 * eh + r32) * 64 + 16 * d0 + 8 * hi);
                  wi[d0] = *(const bf16x8*)(WG + ((size_t)(n * 2 + 1) * 64 + 32 * eh + r32) * 64 + 16 * d0 + 8 * hi);
              }
#pragma unroll
              for (int d0 = 0; d0 < 4; ++d0) { Rg = __builtin_amdgcn_mfma_f32_32x32x16_bf16(xa[d0], wr[d0], Rg, 0, 0, 0); Ig = __builtin_amdgcn_mfma_f32_32x32x16_bf16(xa[d0], wi[d0], Ig, 0, 0, 0); } }
#pragma unroll
            for (int r = 0; r < 16; ++r) {
                const float xv = xl[crow(r, hi) * XLS + 32 * eh + r32];
                const float rg = sigm(Rg[r] + brg[eh]), ig = sigm(Ig[r] + big[eh]);
                const float la = cl[eh] * rg;
                const float a = ex2(la * LOG2E);
                const float x2 = 2.f * la;
                const float poly = -x2 * (1.f + x2 * (0.5f + x2 * (0.16666667f + x2 * (0.041666668f + x2 * (0.008333334f + x2 * 0.0013888889f)))));
                const float om = (x2 > -0.3f) ? poly : 1.f - a * a;
                av[tile][eh][r] = a; uvt[r] = __builtin_amdgcn_sqrtf(om) * ig * xv;
            }
#pragma unroll
            for (int r = 0; r < 8; ++r) up[tile][eh][r] = pk2(uvt[2 * r], uvt[2 * r + 1]);
            float s = hc[eh], cs = cc[eh];
#pragma unroll
            for (int g = 0; g < 4; ++g) {
                float A = av[tile][eh][4 * g], U = uvt[4 * g];
#pragma unroll
                for (int k = 1; k < 4; ++k) { U = av[tile][eh][4 * g + k] * U + uvt[4 * g + k]; A *= av[tile][eh][4 * g + k]; }
                const float pA = xor32(A, hi), pU = xor32(U, hi);
                const float loA = hi ? pA : A, loU = hi ? pU : U, hiA = hi ? A : pA, hiU = hi ? U : pU;
                s = loA * s + loU; cs = loA * cs;
                s = hiA * s + hiU; cs = hiA * cs;
            }
            hc[eh] = s; cc[eh] = cs;
#pragma unroll
            for (int r = 0; r < 8; ++r) asm volatile("" : "+v"(up[tile][eh][r]));
            __builtin_amdgcn_sched_barrier(0);
        }
        asm volatile("s_waitcnt lgkmcnt(0)" ::: "memory");
    }
    if ((lane >> 5) == 0) {
#pragma unroll
        for (int eh = 0; eh < 2; ++eh) {
            const int ch = n * 64 + 32 * eh + (lane & 31);
            PH[((size_t)b * NCHUNK + c) * LRU_W + ch] = cc[eh];
            PH[(size_t)BATCH * NCHUNK * LRU_W + ((size_t)b * NCHUNK + c) * LRU_W + ch] = hc[eh];
        }
    }
}
__device__ __forceinline__ void lru_stage_b(int b, int n, int c, const bf16_t* P, const float* PH, bf16_t* Y, LAS unsigned char* wl, int lane, const float (&av)[2][2][16], const unsigned (&up)[2][2][8]) {
    asm volatile("" : "+v"(lane));
    const int r32 = lane & 31, hi = lane >> 5;
    LAS float* xl = (LAS float*)wl;
    float hc[2] = {0.f, 0.f};
    if (c > 0) {
        const float* pa0 = PH + (size_t)b * NCHUNK * LRU_W + n * 64 + r32; const float* ph0 = pa0 + (size_t)BATCH * NCHUNK * LRU_W;
        const int mid = (c + 1) >> 1, lo_ = hi ? mid : 0, hi_ = hi ? c : mid;
        float A[2] = {1.f, 1.f}, U[2] = {0.f, 0.f};
        for (int c0 = lo_; c0 < hi_; c0 += 16) {
            float pv[2][16], hv[2][16];
#pragma unroll
            for (int j = 0; j < 16; ++j) { const int cp = c0 + j < hi_ ? c0 + j : c0;
#pragma unroll
                for (int eh = 0; eh < 2; ++eh) { pv[eh][j] = pa0[cp * LRU_W + 32 * eh]; hv[eh][j] = ph0[cp * LRU_W + 32 * eh]; } }
#pragma unroll
            for (int j = 0; j < 16; ++j) if (c0 + j < hi_) {
#pragma unroll
                for (int eh = 0; eh < 2; ++eh) { U[eh] = pv[eh][j] * U[eh] + hv[eh][j]; A[eh] *= pv[eh][j]; } }
        }
#pragma unroll
        for (int eh = 0; eh < 2; ++eh) {
            const float Uo = xor32(U[eh], hi), Ao = xor32(A[eh], hi);
            hc[eh] = hi ? A[eh] * Uo + U[eh] : Ao * U[eh] + Uo;
        }
    }
#pragma unroll
    for (int tile = 0; tile < CHUNK / 32; ++tile) {
        const size_t row0 = (size_t)b * SEQ + (size_t)c * CHUNK + tile * 32;
#pragma unroll
        for (int eh = 0; eh < 2; ++eh) {
            float uvt[16];
#pragma unroll
            for (int r = 0; r < 8; ++r) { uvt[2 * r] = bflo(up[tile][eh][r]); uvt[2 * r + 1] = bfhi(up[tile][eh][r]); }
            float Ag[4], Ug[4], pA[4], pU[4];
#pragma unroll
            for (int g = 0; g < 4; ++g) {
                float A = av[tile][eh][4 * g], U = uvt[4 * g];
#pragma unroll
                for (int k = 1; k < 4; ++k) { U = av[tile][eh][4 * g + k] * U + uvt[4 * g + k]; A *= av[tile][eh][4 * g + k]; }
                Ag[g] = A; Ug[g] = U; pA[g] = xor32(A, hi); pU[g] = xor32(U, hi);
            }
            float s = hc[eh];
#pragma unroll
            for (int g = 0; g < 4; ++g) {
                const float loA = hi ? pA[g] : Ag[g], loU = hi ? pU[g] : Ug[g], hiA = hi ? Ag[g] : pA[g], hiU = hi ? Ug[g] : pU[g];
                const float in_lo = s;
                s = loA * s + loU;
                const float in_hi = s;
                s = hiA * s + hiU;
                float hh = hi ? in_hi : in_lo;
#pragma unroll
                for (int k = 0; k < 4; ++k) { const int r = 4 * g + k; hh = av[tile][eh][r] * hh + uvt[r]; xl[crow(r, hi) * XLS + 32 * eh + r32] = hh; }
            }
            hc[eh] = s;
        }
        asm volatile("s_waitcnt lgkmcnt(0)" ::: "memory");
#pragma unroll
        for (int d0 = 0; d0 < 4; ++d0) {
            const int cb = 16 * d0 + 8 * hi;
            const f32x4 h0 = *(LAS f32x4*)(xl + r32 * XLS + cb), h1 = *(LAS f32x4*)(xl + r32 * XLS + cb + 4);
            const u32x4 gv = *(const u32x4*)(P + (row0 + r32) * DIN + C_LG + n * 64 + cb);
            u32x4 w;
            w.x = pk2(h0.x * bflo(gv.x), h0.y * bfhi(gv.x)); w.y = pk2(h0.z * bflo(gv.y), h0.w * bfhi(gv.y));
            w.z = pk2(h1.x * bflo(gv.z), h1.y * bfhi(gv.z)); w.w = pk2(h1.z * bflo(gv.w), h1.w * bfhi(gv.w));
            *(u32x4*)(Y + (row0 + r32) * DM + 512 + n * 64 + cb) = w;
        }
        asm volatile("s_waitcnt lgkmcnt(0)" ::: "memory");
    }
}

#define RLX_AGENT __ATOMIC_RELAXED, __HIP_MEMORY_SCOPE_AGENT
#define LDS_WAIT() asm volatile("s_waitcnt lgkmcnt(0)" ::: "memory")
#define VM_WAIT() asm volatile("s_waitcnt vmcnt(0)" ::: "memory")
#define XB_TMO      128
#define XB_XCNT(j)  (256  + 64 * (j))
#define XB_XSUB(j)  (1280 + 64 * (j))
#define XB_XGEN(j)  (2304 + 64 * (j))
#define XB_TOP      3328
#define XB_TOPGEN   3392
#define XCD_BAR_WORDS 3456
#define XB_SPIN_CAP (1u << 18)

__device__ __forceinline__ unsigned xb_ld(unsigned* p)              { return __hip_atomic_load(p, __ATOMIC_RELAXED, __HIP_MEMORY_SCOPE_AGENT); }
__device__ __forceinline__ unsigned xb_add(unsigned* p, unsigned v) { return __hip_atomic_fetch_add(p, v, __ATOMIC_RELAXED, __HIP_MEMORY_SCOPE_AGENT); }
__device__ __forceinline__ unsigned xb_xcc_id() { return (unsigned)__builtin_amdgcn_s_getreg((3 << 11) | 20) & 0xFu; }
#define XB_SPIN(cond, bar) do { unsigned _sp = 0; while (cond) { __builtin_amdgcn_s_sleep(1); \
    if ((++_sp & 255u) == 0u) { if (xb_ld(&(bar)[XB_TMO])) break; if (_sp > XB_SPIN_CAP) { atomicAdd(&(bar)[XB_TMO], 1u); break; } } } } while (0)

struct XcdBarrier {
    unsigned* bar; unsigned x;
    volatile LAS unsigned* st;
};

__device__ __forceinline__ XcdBarrier xcd_barrier_post(unsigned* bar, volatile LAS unsigned* st) {
    XcdBarrier b; b.bar = bar; b.x = xb_xcc_id(); b.st = st;
    if (threadIdx.x == 0) (void)xb_add(&bar[XB_XCNT(b.x)], 1u);
    return b;
}
__device__ __forceinline__ void xcd_barrier_complete(unsigned* bar, unsigned x, unsigned& nloc, unsigned& nx) {
    const unsigned G = gridDim.x * gridDim.y * gridDim.z;
    unsigned sum, cnt, mine, sp = 0u;
    for (;;) {
        sum = 0u; cnt = 0u; mine = 0u;
#pragma unroll
        for (unsigned j = 0; j < 16; ++j) { const unsigned c = xb_ld(&bar[XB_XCNT(j)]); sum += c; cnt += (c > 0u) ? 1u : 0u; mine = (j == x) ? c : mine; }
        if (sum == G) break;
        __builtin_amdgcn_s_sleep(1);
        if ((++sp & 255u) == 0u) { if (xb_ld(&bar[XB_TMO])) break; if (sp > XB_SPIN_CAP) { atomicAdd(&bar[XB_TMO], 1u); break; } }
    }
    nloc = mine > 0u ? mine : 1u; nx = cnt > 0u ? cnt : 1u;
}

__device__ __forceinline__ void xcd_barrier(const XcdBarrier& b) {
    asm volatile("s_waitcnt vmcnt(0)" ::: "memory");
    __syncthreads();
    if (threadIdx.x == 0) {
        unsigned* bar = b.bar;
        __builtin_amdgcn_s_waitcnt(0);
        unsigned nloc = b.st[0], nx = b.st[1];
        if (nloc == 0u) { xcd_barrier_complete(bar, b.x, nloc, nx); b.st[0] = nloc; b.st[1] = nx; }
        const unsigned old = xb_add(&bar[XB_XSUB(b.x)], 1u);
        const unsigned gen = old / nloc;
        if (old + 1u == (gen + 1u) * nloc) {
            __builtin_amdgcn_fence(__ATOMIC_RELEASE, "agent");
            asm volatile("s_waitcnt vmcnt(0)" ::: "memory");
            const unsigned og = xb_add(&bar[XB_TOP], 1u);
            const unsigned tg = og / nx;
            if (og + 1u == (tg + 1u) * nx) xb_add(&bar[XB_TOPGEN], 1u);
            else XB_SPIN(xb_ld(&bar[XB_TOPGEN]) == tg, bar);
            __builtin_amdgcn_fence(__ATOMIC_ACQUIRE, "agent");
            xb_add(&bar[XB_XGEN(b.x)], 1u);
            asm volatile("s_waitcnt vmcnt(0)" ::: "memory");
        } else {
            XB_SPIN(xb_ld(&bar[XB_XGEN(b.x)]) == gen, bar);
            __builtin_amdgcn_fence(__ATOMIC_ACQUIRE, "agent");
            asm volatile("s_waitcnt vmcnt(0)" ::: "memory");
        }
    }
    __syncthreads();
}

struct Args { const float* in[18]; float* out; unsigned char* ws; int ph_lo, ph_hi, dup, pad; };
constexpr int LDS_BYTES = LDS_MISC + 256;
constexpr int N_PHASES = 9;

__global__ void __launch_bounds__(512, 2) hymba_fwd(Args a) {
    extern __shared__ __attribute__((aligned(16))) unsigned char lds_raw[];
    LAS unsigned char* lds = (LAS unsigned char*)lds_raw;
    cg::grid_group grid = cg::this_grid();
    const int tid = threadIdx.x, lane = tid & 63, wave = __builtin_amdgcn_readfirstlane(tid >> 6);
    const int G = gridDim.x, gw = blockIdx.x * 8 + wave, NGW = G * 8;
    unsigned char* ws = a.ws;
    const float* x_in = a.in[0]; const float* mem = a.in[1];
    bf16_t* WIN0 = (bf16_t*)(ws + WS_WIN0); bf16_t* WIN1 = (bf16_t*)(ws + WS_WIN1); bf16_t* WOUT = (bf16_t*)(ws + WS_WOUT); bf16_t* WGT = (bf16_t*)(ws + WS_WG);
    float* SS = (float*)(ws + WS_SS); float* MRS = (float*)(ws + WS_MRS); float* PHB = (float*)(ws + WS_PH);
    bf16_t* KV = (bf16_t*)(ws + WS_KV); bf16_t* XB = (bf16_t*)(ws + WS_XB); bf16_t* PROJ = (bf16_t*)(ws + WS_PROJ); bf16_t* Y = (bf16_t*)(ws + WS_Y);
    LAS unsigned char* wl = lds + wave * 18432;
    volatile LAS unsigned* MISC = (volatile LAS unsigned*)(lds + LDS_MISC);
    if (tid < 64) MISC[tid] = 0u;
    __syncthreads();
    unsigned* barw = (unsigned*)(ws + WS_BAR);
    const XcdBarrier bar = xcd_barrier_post(barw, MISC);
    if (a.dup & 256) grid.sync();
#define RUN(k) (a.ph_lo <= (k) && (k) < a.ph_hi)
#define REPS(bit) (1 + ((a.dup >> (bit)) & 1))
#define SEAM(k) do { if (RUN(k) && RUN((k) + 1)) { xcd_barrier(bar); if (a.dup & 128) { xcd_barrier(bar); xcd_barrier(bar); } } } while (0)

    if (RUN(0)) {
#pragma unroll 1
      for (int rep = 0; rep < REPS(0); ++rep) {
        int lane0 = lane; asm volatile("" : "+v"(lane0));
        LAS float* scr = (LAS float*)wl;
        constexpr int I_IN = 16 * 48, I_OUT = 16 * 16, I_KV = 16 * 8, I_G = 16;
        constexpr int NITEMS = 2 * (I_IN + I_OUT + I_KV) + I_G;
        for (int it = (gw + NGW / 2) % NGW; it < NITEMS; it += NGW) {
            int r = it;
            if (r < 2 * I_IN) { const int l = r / I_IN; p0_transpose_item(a.in[3] + (size_t)l * DM * DIN, DM, DIN, l ? WIN1 : WIN0, 0, a.in[2] + l * DM, true, scr, r % I_IN, lane); }
            else if ((r -= 2 * I_IN) < 2 * I_OUT) { const int l = r / I_OUT; p0_transpose_item(a.in[17] + (size_t)l * DM * DM, DM, DM, WOUT + (size_t)l * DM * DM, 0, nullptr, false, scr, r % I_OUT, lane); }
            else if ((r -= 2 * I_OUT) < 2 * I_KV) { const int l = r / I_KV; p0_transpose_item(a.in[16] + (size_t)l * DM * 512, DM, 512, WIN0, 3072 + 512 * l, a.in[15] + l * DM, true, scr, r % I_KV, lane); }
            else { r -= 2 * I_KV; const int l = r >> 3, n = (r >> 1) & 3, kind = r & 1;
              p0_transpose_item(a.in[kind ? 10 : 8] + (size_t)(l * 4 + n) * 4096, 64, 64, WGT + (size_t)((l * 4 + n) * 2 + kind) * 4096, 0, nullptr, false, scr, 0, lane); }
        }
        for (int m4 = gw * 4; m4 < MTOK + MMEM; m4 += NGW * 4) {
          if (m4 < MTOK + MMEM) {
            f32x4 v[4][4]; float sq[4];
#pragma unroll
            for (int q = 0; q < 4; ++q) {
                const int m = m4 + q;
                const float* src = m < MTOK ? x_in + (size_t)m * DM : mem + (size_t)(m - MTOK) * DM;
                const f32x4* xr = (const f32x4*)src + lane;
#pragma unroll
                for (int j = 0; j < 4; ++j) v[q][j] = xr[64 * j];
            }
#pragma unroll
            for (int q = 0; q < 4; ++q) {
                float s = 0.f;
#pragma unroll
                for (int j = 0; j < 4; ++j) s += (v[q][j].x * v[q][j].x + v[q][j].y * v[q][j].y) + (v[q][j].z * v[q][j].z + v[q][j].w * v[q][j].w);
                sq[q] = s;
            }
#pragma unroll
            for (int o = 1; o < 64; o <<= 1) {
#pragma unroll
                for (int q = 0; q < 4; ++q) sq[q] += __shfl_xor(sq[q], o);
            }
#pragma unroll
            for (int q = 0; q < 4; ++q) {
                const int m = m4 + q;
                u32x2* o8 = (u32x2*)(XB + (size_t)m * DM) + lane;
#pragma unroll
                for (int j = 0; j < 4; ++j) { u32x2 w; w.x = pk2(v[q][j].x, v[q][j].y); w.y = pk2(v[q][j].z, v[q][j].w); o8[64 * j] = w; }
                if (m < MTOK) { if (lane < 16) SS[(size_t)m * 16 + lane] = lane == 0 ? sq[q] : 0.f; }
                else if (lane == 0) MRS[m - MTOK] = rsqrtf(sq[q] * (1.f / 1024.f) + EPS);
            }
        }
        }
      }
    }
    SEAM(0);

#pragma unroll 1
    for (int l = 0; l < 2; ++l) {
        const int pb = 1 + 4 * l;
        if (RUN(pb)) {
            pg8::Gemm g{XB, l ? WIN1 : WIN0, MTOK, DIN, DM};
            ProjOrder S; S.init(G, (int)blockIdx.x, 0);
            EpiProj E{PROJ, KV, SS, MRS, a.in[4] + l * 64, a.in[5] + l * 64, a.in[13] + l * 64, a.in[14]};
#pragma unroll 1
            for (int rep = 0; rep < REPS(1); ++rep) pg8::gemm_phase<EpiProj, ProjOrder, true, true>(lds, g, S, E);
        }
        SEAM(pb);
        {
            constexpr int U_XA = BATCH * 4 * 8;
            const int bi = (int)blockIdx.x;
            if (l == 0) {
                pg8::Gemm g{XB, WIN0, MTOK, DIN, DM};
                ProjOrder S; S.so.init(MTOK, DIN, G, bi); S.so.nwg = 0; S.extra = 32;
                EpiProj E{PROJ, KV, SS, MRS, a.in[4], a.in[5], a.in[13], a.in[14]};
                pg8::gemm_phase<EpiProj, ProjOrder, true, true>(lds, g, S, E);
            }
            const int nround = (l == 0 && bi < 32) ? 2 : 4, norph = (l == 0 && bi >= 32 && bi < 96) ? 1 : 0;
            {
                u32x4 pk[4], pv[4];
                int tid2 = tid; asm volatile("" : "+v"(tid2));
                int bh, QB; sb_deal(0, nround, bi, bh, QB);
                sb_issue(bh >> 3, bh & 7, QB, PROJ, tid2, pk, pv);
#pragma unroll 1
                for (int r = 0; r < nround + norph; ++r) {
                    int bhn = 0, QBn = 0; const bool has_next = r + 1 < nround + norph;
                    if (has_next) sb_deal(r + 1, nround, bi, bhn, QBn);
                    sb_block(bh >> 3, bh & 7, QB, PROJ, Y, lds, wave, lane, tid2, pk, pv, has_next, bhn >> 3, bhn & 7, QBn);
                    bh = bhn; QB = QBn;
                }
            }
            const int c = gw % NCHUNK, n = (gw / NCHUNK) & 3, b = gw / (NCHUNK * 4);
            float av[2][2][16]; unsigned up[2][2][8];
            lru_stage_a(b, n, c, PROJ, WGT + (size_t)l * 8 * 4096, a.in[6] + (size_t)l * 4 * LRU_W, a.in[7] + l * LRU_W, a.in[9] + l * LRU_W, a.in[11] + l * LRU_W, a.in[12] + l * LRU_W,
                        PHB + (size_t)l * 2 * BATCH * NCHUNK * LRU_W, wl, lane, av, up);
            xcd_barrier(bar);
            lru_stage_b(b, n, c, PROJ, PHB + (size_t)l * 2 * BATCH * NCHUNK * LRU_W, Y, wl, lane, av, up);
            __syncthreads();
#pragma unroll 1
            for (int v = bi; v < U_XA; v += G) {
                const int QB = v & 7, h = (v >> 3) & 3, bx = v >> 5;
                xa_block(bx, h, QB, PROJ, KV + (size_t)l * MMEM * 512, Y, lds, wave, lane, tid);
            }
        }
        xcd_barrier(bar);
        if (RUN(pb + 3)) {
            pg8::Gemm g{Y, WOUT + (size_t)l * DM * DM, MTOK, DM, DM};
            ProjOrder S; S.so.init(MTOK, DM, G, (int)blockIdx.x); S.extra = 0;
            EpiOut E{x_in, XB, a.out, l ? nullptr : XB, l ? nullptr : SS};
#pragma unroll 1
            for (int rep = 0; rep < (l ? 1 : REPS(6)); ++rep) pg8::gemm_phase<EpiOut, ProjOrder, true, true>(lds, g, S, E);
        }
        if (l == 0) SEAM(pb + 3);
    }
#undef RUN
#undef REPS
#undef SEAM
}

#ifndef DUP_MASK
#define DUP_MASK 0
#endif
#ifndef N_LAUNCH_SPLIT
#define N_LAUNCH_SPLIT 0
#endif
extern "C" void kernel_launch(void* const* d_in, const int* in_sizes, int n_in, void* d_out, int out_size, void* d_ws, size_t ws_size, hipStream_t stream) {
    static int grid = 0;
    if (grid == 0) {
        if (n_in != 18 || out_size != MTOK * DM || ws_size < WS_END) { fprintf(stderr, "kernel_launch: unexpected shapes (n_in %d out %d ws %zu)\n", n_in, out_size, ws_size); grid = -1; return; }
        int dev = 0, cus = 0, per_cu = 0;
        hipGetDevice(&dev); hipDeviceGetAttribute(&cus, hipDeviceAttributeMultiprocessorCount, dev);
        if (hipFuncSetAttribute((const void*)hymba_fwd, hipFuncAttributeMaxDynamicSharedMemorySize, LDS_BYTES) != hipSuccess) { fprintf(stderr, "kernel_launch: hipFuncSetAttribute failed\n"); }
        if (hipOccupancyMaxActiveBlocksPerMultiprocessor(&per_cu, (const void*)hymba_fwd, 512, LDS_BYTES) != hipSuccess || per_cu < 1) { fprintf(stderr, "kernel_launch: occupancy query gave %d\n", per_cu); per_cu = 1; }
        (void)hipGetLastError();
        grid = cus * per_cu;
        if (grid != 256) { fprintf(stderr, "kernel_launch: this kernel deals one RG-LRU unit per wave of a 256-workgroup grid; got %d x %d\n", cus, per_cu); grid = -1; return; }
    }
    if (grid < 0) return;
    Args a{};
    for (int i = 0; i < 18; ++i) a.in[i] = (const float*)d_in[i];
    a.out = (float*)d_out; a.ws = (unsigned char*)d_ws; a.dup = DUP_MASK;
#if N_LAUNCH_SPLIT
    for (int p = 0; p < N_PHASES; ++p) { a.ph_lo = p; a.ph_hi = p + 1; hipLaunchKernelGGL(hymba_fwd, dim3(grid), dim3(512), LDS_BYTES, stream, a); }
#else
    a.ph_lo = 0; a.ph_hi = N_PHASES;
    if (hipMemsetAsync((char*)d_ws + WS_BAR, 0, XCD_BAR_WORDS * 4, stream) != hipSuccess) { fprintf(stderr, "kernel_launch: hipMemsetAsync of the barrier words failed\n"); return; }
    void* args[] = {&a};
    hipError_t e = hipLaunchCooperativeKernel((const void*)hymba_fwd, dim3(grid), dim3(512), args, LDS_BYTES, stream);
    if (e != hipSuccess) fprintf(stderr, "kernel_launch: cooperative launch failed: %s (grid %d)\n", hipGetErrorString(e), grid);
#endif
}
```

```cpp
#include <hip/hip_runtime.h>
#include <hip/hip_cooperative_groups.h>
#include <cstdio>
#include <cstdint>
namespace cg = cooperative_groups;
namespace pg8 {
#define PG8_LAS __attribute__((address_space(3)))
typedef unsigned short bf16_t;
typedef short bf16x8 __attribute__((ext_vector_type(8)));
typedef float f32x4 __attribute__((ext_vector_type(4)));
typedef unsigned u32x4 __attribute__((ext_vector_type(4)));
constexpr int BM = 256, BK = 64, HALF = 128, HTB = HALF * BK * 2  , STAGE_BYTES = 8 * HTB, NXCD = 8, WGM = 8;

__host__ __device__ __forceinline__ int lds_byte(int r, int c) { const int st = (r >> 4) * 2 + (c >> 5), rr = r & 15, cc = c & 31, ob = rr * 64 + cc * 2; return st * 1024 + (ob ^ (((ob >> 9) & 1) << 5)); }
__host__ __device__ __forceinline__ void stage_rc(int b, int& R, int& C) { const int st = b / 1024, sb = b % 1024, swz = sb ^ (((sb >> 9) & 1) << 5); R = (st >> 1) * 16 + swz / 64; C = (st & 1) * 32 + (swz % 64) / 2; }
__host__ __device__ __forceinline__ int perm32(int rho) { const int n = rho >> 4, i = rho & 15; return 8 * (i >> 2) + 4 * n + (i & 3); }

struct Unit { int pm, pn; };
struct Gemm { const bf16_t* A; const bf16_t* Bt; int M, N, K; };

struct StaticOrder {
    int nM, nN, nwg, G, c;
    __host__ __device__ void init(int M, int N, int G_, int c_) { nM = M / BM; nN = N / BM; nwg = nM * nN; G = G_; c = c_; }
    __host__ __device__ bool next(int i, Unit& u) const {
        const long L = (long)i * G + c; if (L >= nwg) return false;
        int wgid = (int)L; { const int q = nwg / NXCD, r = nwg % NXCD, xcd = wgid % NXCD, off = wgid / NXCD; wgid = (xcd < r ? xcd * (q + 1) : r * (q + 1) + (xcd - r) * q) + off; }
        const int nig = WGM * nN, gid = wgid / nig, fm = gid * WGM, gsz = (nM - fm) < WGM ? (nM - fm) : WGM;
        u.pm = fm + ((wgid % nig) % gsz); u.pn = (wgid % nig) / gsz; return true;
    }
    __device__ __forceinline__ void a_ready(const Unit&) const {}
    __device__ __forceinline__ void done(const Unit&) const {}
};
__device__ __forceinline__ unsigned cvt_pk_bf16(float lo, float hi) { unsigned r; asm volatile("v_cvt_pk_bf16_f32 %0, %1, %2" : "=v"(r) : "v"(lo), "v"(hi)); return r; }
typedef float f32x2 __attribute__((ext_vector_type(2)));
template <class Epi, class Sched, bool ALIGN_EPI = false, bool SP2 = false>
__device__ __forceinline__ void gemm_phase(PG8_LAS unsigned char* lds, const Gemm g, const Sched& S, const Epi& E) {
    int tid_ = threadIdx.x; asm volatile("" : "+v"(tid_));
    const int tid = tid_, wid = __builtin_amdgcn_readfirstlane(tid >> 6), lane = tid & 63, wr = wid >> 2, wc = wid & 3, fr = lane & 15, fq = lane >> 4;
    const int K = g.K, nt = K / BK;
    unsigned voffA[2], voffB[2];
#pragma unroll
    for (int i = 0; i < 2; ++i) { int R, C; stage_rc(tid * 16 + i * 8192, R, C); const int Rb = Epi::PERM ? ((R & ~31) + perm32(R & 31)) : R;
        voffA[i] = (unsigned)(R * K + C) * 2u; voffB[i] = (unsigned)(Rb * K + C) * 2u; }
    const size_t kstep = (size_t)(BK * 2);
    const size_t hstep = (size_t)HALF * K * 2;
    const size_t tstep = 2 * hstep;
    const unsigned ldsw = (unsigned)wid * 1024u;
    const int aoff = lds_byte(wr * 64 + fr, fq * 8), boff = lds_byte(wc * 32 + fr, fq * 8);
#define PG8_SA(b, h) (((b) * 2 + (h)) * HTB)
#define PG8_SB(b, h) ((4 + (b) * 2 + (h)) * HTB)
#define PG8_STAGE(bufoff, gbase, voff) do { _Pragma("unroll") for (int _i = 0; _i < 2; ++_i) \
        __builtin_amdgcn_global_load_lds((const unsigned*)((const char*)(gbase) + (voff)[_i]), (PG8_LAS unsigned*)(lds + (bufoff) + ldsw + _i * 8192), 16, 0, 0); } while (0)
#define PG8_LDA(dst, b, h) do { _Pragma("unroll") for (int m = 0; m < 4; ++m) _Pragma("unroll") for (int k = 0; k < 2; ++k) dst[m][k] = *(const PG8_LAS bf16x8*)(lds + PG8_SA(b, h) + aoff + m * 2048 + k * 1024); } while (0)
#define PG8_LDB(dst, b, h) do { _Pragma("unroll") for (int n = 0; n < 2; ++n) _Pragma("unroll") for (int k = 0; k < 2; ++k) dst[n][k] = *(const PG8_LAS bf16x8*)(lds + PG8_SB(b, h) + boff + n * 2048 + k * 1024); } while (0)
#define PG8_MMA(ai, bj, At, Bt) do { __builtin_amdgcn_s_setprio(1); _Pragma("unroll") for (int m = 0; m < 4; ++m) _Pragma("unroll") for (int n = 0; n < 2; ++n) _Pragma("unroll") for (int k = 0; k < 2; ++k) \
        acc[ai][bj][m][n] = __builtin_amdgcn_mfma_f32_16x16x32_bf16(Bt[n][k], At[m][k], acc[ai][bj][m][n], 0, 0, 0); __builtin_amdgcn_s_setprio(0); } while (0)
#define PG8_WAIT_V(n) asm volatile("s_waitcnt vmcnt(" #n ")" ::: "memory")
#define PG8_WAIT_L(n) asm volatile("s_waitcnt lgkmcnt(" #n ")" ::: "memory")
#define PG8_BAR __builtin_amdgcn_s_barrier()
#define PG8_SCHED __builtin_amdgcn_sched_barrier(0)
    Unit cur, nxt; int ui = 0;
    if (!S.next(0, cur)) return;
    f32x4 acc[2][2][4][2];
#pragma unroll
    for (int a = 0; a < 2; ++a)
#pragma unroll
        for (int b = 0; b < 2; ++b)
#pragma unroll
            for (int m = 0; m < 4; ++m)
#pragma unroll
                for (int n = 0; n < 2; ++n) acc[a][b][m][n] = (f32x4){0.f, 0.f, 0.f, 0.f};
    bf16x8 At[4][2], B0[2][2], B1[2][2];
    const char* cA = (const char*)g.A + (size_t)cur.pm * tstep; const char* cB = (const char*)g.Bt + (size_t)cur.pn * tstep;
    S.a_ready(cur);
    if constexpr (SP2) {
        PG8_STAGE(PG8_SB(0, 0), cB, voffB); PG8_STAGE(PG8_SB(0, 1), cB + hstep, voffB); PG8_STAGE(PG8_SA(0, 0), cA, voffA); PG8_STAGE(PG8_SA(0, 1), cA + hstep, voffA);
        if (wr == 1) PG8_BAR;
        PG8_WAIT_V(2); PG8_BAR;
        PG8_STAGE(PG8_SB(1, 0), cB + kstep, voffB); PG8_STAGE(PG8_SA(1, 0), cA + kstep, voffA); PG8_STAGE(PG8_SB(1, 1), cB + hstep + kstep, voffB);
        PG8_WAIT_V(6); PG8_BAR;
    } else {
        PG8_STAGE(PG8_SB(0, 0), cB, voffB); PG8_STAGE(PG8_SA(0, 0), cA, voffA); PG8_STAGE(PG8_SB(0, 1), cB + hstep, voffB); PG8_STAGE(PG8_SA(0, 1), cA + hstep, voffA);
        if (wr == 1) PG8_BAR;
        PG8_WAIT_V(4); PG8_BAR;
        PG8_STAGE(PG8_SB(1, 0), cB + kstep, voffB); PG8_STAGE(PG8_SA(1, 0), cA + kstep, voffA); PG8_STAGE(PG8_SB(1, 1), cB + hstep + kstep, voffB);
        PG8_WAIT_V(6); PG8_BAR;
    }
    for (;;) {
        const bool has_next = S.next(ui + 1, nxt);
        const char* nA = has_next ? (const char*)g.A + (size_t)nxt.pm * tstep : cA; const char* nB = has_next ? (const char*)g.Bt + (size_t)nxt.pn * tstep : cB;
        for (int t = 0; t < nt; t += 2) {
            const bool last = (t == nt - 2);
            const char* a1 = cA + (size_t)(t + 1) * kstep;
            const char* a2 = last ? nA : cA + (size_t)(t + 2) * kstep; const char* b2 = last ? nB : cB + (size_t)(t + 2) * kstep;
            const char* a3 = a2 + kstep; const char* b3 = b2 + kstep;
            if (last && has_next) S.a_ready(nxt);
            if constexpr (SP2) {
            PG8_LDB(B0, 0, 0); PG8_LDB(B1, 0, 1); PG8_SCHED; PG8_LDA(At, 0, 0); PG8_STAGE(PG8_SA(1, 1), a1 + hstep, voffA);
            PG8_WAIT_V(8); PG8_WAIT_L(0); PG8_BAR; PG8_MMA(0, 0, At, B0); PG8_MMA(0, 1, At, B1); PG8_BAR; PG8_SCHED;
            PG8_LDA(At, 0, 1); PG8_STAGE(PG8_SB(0, 0), b2, voffB); PG8_STAGE(PG8_SB(0, 1), b2 + hstep, voffB); PG8_STAGE(PG8_SA(0, 0), a2, voffA);
            PG8_WAIT_V(8); PG8_WAIT_L(0); PG8_BAR; PG8_MMA(1, 0, At, B0); PG8_MMA(1, 1, At, B1); PG8_BAR; PG8_SCHED;
            PG8_LDB(B0, 1, 0); PG8_LDB(B1, 1, 1); PG8_SCHED; PG8_LDA(At, 1, 0); PG8_STAGE(PG8_SA(0, 1), a2 + hstep, voffA);
            PG8_WAIT_V(8); PG8_WAIT_L(0); PG8_BAR; PG8_MMA(0, 0, At, B0); PG8_MMA(0, 1, At, B1); PG8_BAR; PG8_SCHED;
            PG8_LDA(At, 1, 1); PG8_STAGE(PG8_SB(1, 0), b3, voffB); PG8_STAGE(PG8_SB(1, 1), b3 + hstep, voffB); PG8_STAGE(PG8_SA(1, 0), a3, voffA);
            PG8_WAIT_V(8); PG8_WAIT_L(0); PG8_BAR; PG8_MMA(1, 0, At, B0); PG8_MMA(1, 1, At, B1); PG8_BAR; PG8_SCHED;
            } else {
            PG8_LDB(B0, 0, 0); PG8_SCHED; PG8_LDA(At, 0, 0); PG8_STAGE(PG8_SA(1, 1), a1 + hstep, voffA);
            PG8_WAIT_L(8); PG8_BAR; PG8_WAIT_L(0); PG8_MMA(0, 0, At, B0); PG8_BAR; PG8_SCHED;
            PG8_LDB(B1, 0, 1); PG8_STAGE(PG8_SB(0, 0), b2, voffB);
            PG8_BAR; PG8_WAIT_L(0); PG8_MMA(0, 1, At, B1); PG8_BAR;
            PG8_LDA(At, 0, 1); PG8_STAGE(PG8_SA(0, 0), a2, voffA);
            PG8_BAR; PG8_WAIT_L(0); PG8_MMA(1, 0, At, B0); PG8_BAR; PG8_SCHED;
            PG8_STAGE(PG8_SB(0, 1), b2 + hstep, voffB);
            PG8_WAIT_V(6); PG8_BAR; PG8_MMA(1, 1, At, B1); PG8_BAR;
            PG8_LDB(B0, 1, 0); PG8_SCHED; PG8_LDA(At, 1, 0); PG8_STAGE(PG8_SA(0, 1), a2 + hstep, voffA);
            PG8_WAIT_L(8); PG8_BAR; PG8_WAIT_L(0); PG8_MMA(0, 0, At, B0); PG8_BAR; PG8_SCHED;
            PG8_LDB(B1, 1, 1); PG8_STAGE(PG8_SB(1, 0), b3, voffB);
            PG8_BAR; PG8_WAIT_L(0); PG8_MMA(0, 1, At, B1); PG8_BAR;
            PG8_LDA(At, 1, 1); PG8_STAGE(PG8_SA(1, 0), a3, voffA);
            PG8_BAR; PG8_WAIT_L(0); PG8_MMA(1, 0, At, B0); PG8_BAR; PG8_SCHED;
            PG8_STAGE(PG8_SB(1, 1), b3 + hstep, voffB);
            PG8_WAIT_V(6); PG8_BAR; PG8_MMA(1, 1, At, B1); PG8_BAR;
            }
        }
        if constexpr (ALIGN_EPI) { if (wr == 0) PG8_BAR; }
        if constexpr (!Epi::AFTER_DRAIN) { E(acc, cur, wr, wc, fr, fq); S.done(cur); }
        if (!has_next) break;
#pragma unroll
        for (int a = 0; a < 2; ++a)
#pragma unroll
            for (int b = 0; b < 2; ++b)
#pragma unroll
                for (int m = 0; m < 4; ++m)
#pragma unroll
                    for (int n = 0; n < 2; ++n) acc[a][b][m][n] = (f32x4){0.f, 0.f, 0.f, 0.f};
        cur = nxt; cA = nA; cB = nB; ++ui;
        if constexpr (ALIGN_EPI) { if (wr == 1) PG8_BAR; }
    }
    PG8_WAIT_V(0);
    if constexpr (!ALIGN_EPI) { if (wr == 0) PG8_BAR; }
    PG8_BAR;
    if constexpr (Epi::AFTER_DRAIN) { E.fused(acc, cur, wr, wc, fr, fq, lds, wid, lane); S.done(cur); }
#undef PG8_SA
#undef PG8_SB
#undef PG8_STAGE
#undef PG8_LDA
#undef PG8_LDB
#undef PG8_MMA
#undef PG8_WAIT_V
#undef PG8_WAIT_L
#undef PG8_BAR
#undef PG8_SCHED
}
}

constexpr int BATCH = 8, SEQ = 4096, DM = 1024, DIN = 3072, NMEM = 256;
constexpr int MTOK = BATCH * SEQ;
constexpr int MMEM = BATCH * NMEM;
constexpr int LRU_W = 256, CHUNK = 64, NCHUNK = SEQ / CHUNK;
constexpr float EPS = 1e-6f, LOG2E = 1.4426950408889634f, LN2 = 0.6931471805599453f;
constexpr int C_SBQ = 0, C_SBK = 512, C_SBV = 1024, C_SBG = 1536, C_LX = 2048, C_LG = 2304, C_XQ = 2560, C_XG = 2816;

constexpr size_t MiB = 1u << 20;
constexpr size_t WS_WIN0 = 0;
constexpr size_t WS_WIN1 = 8 * MiB;
constexpr size_t WS_WOUT = 14 * MiB;
constexpr size_t WS_WG = 18 * MiB;
constexpr size_t WS_SS = 19 * MiB;
constexpr size_t WS_MRS = 21 * MiB;
constexpr size_t WS_PH = 420 * MiB;
constexpr size_t WS_BAR = 23 * MiB;
constexpr size_t WS_KV = 24 * MiB;
constexpr size_t WS_XB = 32 * MiB;
constexpr size_t WS_PROJ = 100 * MiB;
constexpr size_t WS_Y = 292 * MiB;
constexpr size_t WS_END = 424 * MiB;

#define LAS __attribute__((address_space(3)))
typedef unsigned short bf16_t;
typedef short bf16x8 __attribute__((ext_vector_type(8)));
typedef float f32x16 __attribute__((ext_vector_type(16)));
typedef float f32x4 __attribute__((ext_vector_type(4)));
typedef float f32x2 __attribute__((ext_vector_type(2)));
typedef unsigned u32x4 __attribute__((ext_vector_type(4)));
typedef unsigned u32x2 __attribute__((ext_vector_type(2)));
typedef short v4i16_t __attribute__((ext_vector_type(4)));
typedef __bf16 bf16x2_t __attribute__((ext_vector_type(2)));

__device__ __forceinline__ unsigned pk2(float lo, float hi) { f32x2 v = {lo, hi}; bf16x2_t b = __builtin_convertvector(v, bf16x2_t); return __builtin_bit_cast(unsigned, b); }
__device__ __forceinline__ float bflo(unsigned u) { return __uint_as_float(u << 16); }
__device__ __forceinline__ float bfhi(unsigned u) { return __uint_as_float(u & 0xffff0000u); }
__device__ __forceinline__ float ex2(float x) { return __builtin_amdgcn_exp2f(x); }
__device__ __forceinline__ float lg2(float x) { return __builtin_amdgcn_logf(x); }
__device__ __forceinline__ float silu(float g) { return g * __builtin_amdgcn_rcpf(1.f + ex2(-g * LOG2E)); }
__device__ __forceinline__ float sigm(float g) { return __builtin_amdgcn_rcpf(1.f + ex2(-g * LOG2E)); }
__device__ __forceinline__ int crow(int r, int hi) { return (r & 3) + 8 * (r >> 2) + 4 * hi; }

constexpr float QSCALE = 0.125f * 1.4426950408889634f;
__host__ __device__ __forceinline__ int phys_col(int c) { return (c & ~0xE0) | (((c >> 5) & 1) << 7) | (((c >> 6) & 3) << 5); }
struct EpiProj {
    static constexpr bool PERM = true, AFTER_DRAIN = false;
    bf16_t* proj; bf16_t* kvmem; const float* sspart; const float* memrstd; const float* qg; const float* kg; const float* xqg; const float* xkg2;
    __device__ __forceinline__ void operator()(const pg8::f32x4 (&acc)[2][2][4][2], const pg8::Unit& u, int wr, int wc, int fr, int fq) const {
        const bool ismem = u.pm >= 128;
        const float* gp = nullptr; float nscale = 1.f;
        if (!ismem) { if (u.pn < 2) { gp = qg; nscale = QSCALE; } else if (u.pn < 4) gp = kg; else if (u.pn == 10) { gp = xqg; nscale = QSCALE; } }
        else { const int t = u.pn - 12; if ((t & 1) == 0) gp = xkg2 + (t >> 1) * 64; }
        const bool isgate = !ismem && (u.pn == 6 || u.pn == 7 || u.pn == 9 || u.pn == 11);
        f32x4 gv[2][2];
#pragma unroll
        for (int bj = 0; bj < 2; ++bj)
#pragma unroll
            for (int n = 0; n < 2; ++n) gv[bj][n] = gp ? *(const f32x4*)(gp + 32 * bj + 8 * fq + 4 * n) : (f32x4){1.f, 1.f, 1.f, 1.f};
        float rsv[2][4];
        if (!ismem) {
            f32x4 pv[2][4];
#pragma unroll
            for (int ai = 0; ai < 2; ++ai)
#pragma unroll
                for (int m = 0; m < 4; ++m) pv[ai][m] = *(const f32x4*)(sspart + (size_t)(u.pm * 256 + ai * 128 + wr * 64 + m * 16 + fr) * 16 + 4 * fq);
#pragma unroll
            for (int ai = 0; ai < 2; ++ai)
#pragma unroll
                for (int m = 0; m < 4; ++m) { float ss = (pv[ai][m].x + pv[ai][m].y) + (pv[ai][m].z + pv[ai][m].w); ss += __shfl_xor(ss, 16); ss += __shfl_xor(ss, 32); rsv[ai][m] = rsqrtf(ss * (1.f / 1024.f) + EPS); }
        } else {
#pragma unroll
            for (int ai = 0; ai < 2; ++ai)
#pragma unroll
                for (int m = 0; m < 4; ++m) rsv[ai][m] = memrstd[u.pm * 256 + ai * 128 + wr * 64 + m * 16 + fr - MTOK];
        }
#pragma unroll
        for (int ai = 0; ai < 2; ++ai)
#pragma unroll
            for (int m = 0; m < 4; ++m) {
                const int row = u.pm * 256 + ai * 128 + wr * 64 + m * 16 + fr;
                const float rs = rsv[ai][m]; bf16_t* rowp;
                if (!ismem) {
                    rowp = proj + (size_t)row * DIN + u.pn * 256 + wc * 64 + 8 * fq;
                } else {
                    const int mr = row - MTOK, t = u.pn - 12;
                    rowp = kvmem + (size_t)(t >> 1) * (MMEM * 512) + (size_t)mr * 512 + (t & 1) * 256 + wc * 64 + 8 * fq;
                }
                pg8::f32x4 v[2][2];
#pragma unroll
                for (int bj = 0; bj < 2; ++bj)
#pragma unroll
                    for (int n = 0; n < 2; ++n) v[bj][n] = acc[ai][bj][m][n] * rs;
                if (isgate) {
#pragma unroll
                    for (int bj = 0; bj < 2; ++bj)
#pragma unroll
                        for (int n = 0; n < 2; ++n) { v[bj][n][0] = silu(v[bj][n][0]); v[bj][n][1] = silu(v[bj][n][1]); v[bj][n][2] = silu(v[bj][n][2]); v[bj][n][3] = silu(v[bj][n][3]); }
                }
                if (gp) {
                    float ss = 0.f;
#pragma unroll
                    for (int bj = 0; bj < 2; ++bj)
#pragma unroll
                        for (int n = 0; n < 2; ++n) ss += (v[bj][n][0] * v[bj][n][0] + v[bj][n][1] * v[bj][n][1]) + (v[bj][n][2] * v[bj][n][2] + v[bj][n][3] * v[bj][n][3]);
                    ss += __shfl_xor(ss, 16); ss += __shfl_xor(ss, 32);
                    const float rn = rsqrtf(ss * (1.f / 64.f) + EPS) * nscale;
#pragma unroll
                    for (int bj = 0; bj < 2; ++bj)
#pragma unroll
                        for (int n = 0; n < 2; ++n) v[bj][n] = v[bj][n] * rn * gv[bj][n];
                }
#pragma unroll
                for (int bj = 0; bj < 2; ++bj) {
                    u32x4 w; w.x = pk2(v[bj][0][0], v[bj][0][1]); w.y = pk2(v[bj][0][2], v[bj][0][3]); w.z = pk2(v[bj][1][0], v[bj][1][1]); w.w = pk2(v[bj][1][2], v[bj][1][3]);
                    *(u32x4*)(rowp + bj * 32) = w;
                }
            }
    }
};
struct EpiOut {
    static constexpr bool PERM = false, AFTER_DRAIN = false;
    const float* xin; const bf16_t* xinb; float* xout; bf16_t* xb; float* sspart;
    __device__ __forceinline__ void operator()(const pg8::f32x4 (&acc)[2][2][4][2], const pg8::Unit& u, int wr, int wc, int fr, int fq) const {
        const int col0 = u.pn * 256 + wc * 32 + 4 * fq;
#pragma unroll
        for (int ai = 0; ai < 2; ++ai) {
            if (xb) {
                f32x4 rf[4][2][2];
#pragma unroll
                for (int m = 0; m < 4; ++m)
#pragma unroll
                    for (int bj = 0; bj < 2; ++bj)
#pragma unroll
                        for (int n = 0; n < 2; ++n) rf[m][bj][n] = *(const f32x4*)(xin + (size_t)(u.pm * 256 + ai * 128 + wr * 64 + m * 16 + fr) * DM + col0 + bj * 128 + n * 16);
#pragma unroll
                for (int m = 0; m < 4; ++m) {
                    const int row = u.pm * 256 + ai * 128 + wr * 64 + m * 16 + fr;
                    const size_t off = (size_t)row * DM + col0;
                    float ss = 0.f;
#pragma unroll
                    for (int bj = 0; bj < 2; ++bj)
#pragma unroll
                        for (int n = 0; n < 2; ++n) {
                            const f32x4 o = rf[m][bj][n] + acc[ai][bj][m][n];
                            ss += (o.x * o.x + o.y * o.y) + (o.z * o.z + o.w * o.w);
                            u32x2 w; w.x = pk2(o.x, o.y); w.y = pk2(o.z, o.w);
                            *(u32x2*)(xb + off + bj * 128 + n * 16) = w;
                        }
                    ss += __shfl_xor(ss, 16); ss += __shfl_xor(ss, 32); if (fq == 0) sspart[(size_t)row * 16 + u.pn * 4 + wc] = ss;
                }
            } else {
                u32x2 rb[4][2][2];
#pragma unroll
                for (int m = 0; m < 4; ++m)
#pragma unroll
                    for (int bj = 0; bj < 2; ++bj)
#pragma unroll
                        for (int n = 0; n < 2; ++n) rb[m][bj][n] = *(const u32x2*)(xinb + (size_t)(u.pm * 256 + ai * 128 + wr * 64 + m * 16 + fr) * DM + col0 + bj * 128 + n * 16);
#pragma unroll
                for (int m = 0; m < 4; ++m) {
                    const size_t off = (size_t)(u.pm * 256 + ai * 128 + wr * 64 + m * 16 + fr) * DM + col0;
#pragma unroll
                    for (int bj = 0; bj < 2; ++bj)
#pragma unroll
                        for (int n = 0; n < 2; ++n) {
                            const u32x2 r2 = rb[m][bj][n];
                            const f32x4 bs = (f32x4){bflo(r2.x), bfhi(r2.x), bflo(r2.y), bfhi(r2.y)};
                            *(f32x4*)(xout + off + bj * 128 + n * 16) = bs + acc[ai][bj][m][n];
                        }
                }
            }
        }
    }
};
struct ProjOrder {
    pg8::StaticOrder so; int extra;
    __device__ void init(int G, int c, int extra_) { so.init(MTOK, DIN, G, c); extra = extra_; }
    __device__ bool next(int i, pg8::Unit& u) const {
        const long L = (long)i * so.G + so.c;
        if (L < so.nwg) return so.next(i, u);
        const int e = (int)(L - so.nwg); if (e >= extra) return false;
        u.pm = 128 + (e & 7); u.pn = 12 + (e >> 3); return true;
    }
    __device__ __forceinline__ void a_ready(const pg8::Unit&) const {}
    __device__ __forceinline__ void done(const pg8::Unit&) const {}
};

__device__ __forceinline__ float wave_sum(float v) {
#pragma unroll
    for (int o = 1; o < 64; o <<= 1) v += __shfl_xor(v, o);
    return v;
}
__device__ __forceinline__ void p0_transpose_item(const float* W, int K, int N, bf16_t* WT, int row_off, const float* gk, bool perm, LAS float* scr, int item, int lane) {
    const int nblk = N / 64, kb = item / nblk, nb = item % nblk, k0 = 64 * kb, n0 = 64 * nb;
    float v[64];
#pragma unroll
    for (int kk = 0; kk < 64; ++kk) v[kk] = W[(size_t)(k0 + kk) * N + n0 + lane];
    if (gk) {
        const float g = gk[k0 + lane];
#pragma unroll
        for (int kk = 0; kk < 64; ++kk) v[kk] *= __shfl(g, kk);
    }
#pragma unroll
    for (int kk = 0; kk < 64; ++kk) scr[kk * 65 + lane] = v[kk];
    asm volatile("s_waitcnt lgkmcnt(0)" ::: "memory");
    const int c = lane & 7;
#pragma unroll
    for (int j = 0; j < 8; ++j) { const int n = (lane >> 3) + 8 * j; const LAS float* s = scr + (8 * c) * 65 + n;
        u32x4 o; o.x = pk2(s[0 * 65], s[1 * 65]); o.y = pk2(s[2 * 65], s[3 * 65]); o.z = pk2(s[4 * 65], s[5 * 65]); o.w = pk2(s[6 * 65], s[7 * 65]);
        *(u32x4*)(WT + (size_t)(row_off + (perm ? phys_col(n0 + n) : n0 + n)) * K + k0 + 8 * c) = o; }
    asm volatile("s_waitcnt lgkmcnt(0)" ::: "memory");
}

__device__ __forceinline__ void ld_frag(const bf16_t* p, bf16x8 (&f)[4]) {
#pragma unroll
    for (int d0 = 0; d0 < 4; ++d0) f[d0] = *(const bf16x8*)(p + 16 * d0);
}
constexpr int VRS = 144;
constexpr int TILE_B = 32 * VRS;
constexpr int SB_WIN = 13;
constexpr int LDS_KIMG = 0, LDS_VIMG = SB_WIN * TILE_B, LDS_WTILE = 2 * SB_WIN * TILE_B, LDS_MISC = LDS_WTILE + 8 * TILE_B;
__device__ __forceinline__ float xor32(float v, int hi) {
    auto rr = __builtin_amdgcn_permlane32_swap(__float_as_uint(v), __float_as_uint(v), false, false);
    return __uint_as_float(hi ? rr[0] : rr[1]);
}
__device__ __forceinline__ void lds_frag(LAS unsigned char* tile, int lane, bf16x8 (&f)[4]) {
    LAS unsigned char* p = tile + (lane & 31) * VRS + 16 * (lane >> 5);
#pragma unroll
    for (int d0 = 0; d0 < 4; ++d0) f[d0] = *(LAS bf16x8*)(p + 32 * d0);
}
__device__ __forceinline__ void pv_tile(LAS unsigned char* vt, int lane, const bf16x8 (&pw)[2], f32x16 (&o)[2]) {
    const int hi = lane >> 5, q = (lane & 15) >> 2, p = lane & 3;
    LAS unsigned char* tb = vt + (4 * hi + q) * VRS + (16 * ((lane >> 4) & 1) + 4 * p) * 2;
#pragma unroll
    for (int s = 0; s < 2; ++s)
#pragma unroll
        for (int dh = 0; dh < 2; ++dh) {
            LAS unsigned char* a0 = tb + (16 * s) * VRS + 64 * dh;
            const v4i16_t lo = __builtin_amdgcn_ds_read_tr16_b64_v4i16((LAS v4i16_t*)a0);
            const v4i16_t hh = __builtin_amdgcn_ds_read_tr16_b64_v4i16((LAS v4i16_t*)(a0 + 8 * VRS));
            const bf16x8 vf = (bf16x8){lo[0], lo[1], lo[2], lo[3], hh[0], hh[1], hh[2], hh[3]};
            __builtin_amdgcn_s_setprio(1);
            o[dh] = __builtin_amdgcn_mfma_f32_32x32x16_bf16(vf, pw[s], o[dh], 0, 0, 0);
            __builtin_amdgcn_s_setprio(0);
        }
}
__device__ __forceinline__ void stage_kv(const bf16_t* src, size_t ld, int voff, int nrows, LAS unsigned char* lds, int tid) {
    for (int idx = tid; idx < nrows * 8; idx += 512) {
        const int row = idx >> 3, ch = idx & 7;
        const bf16_t* sp = src + (size_t)row * ld + ch * 8;
        const u32x4 kv = *(const u32x4*)sp, vv = *(const u32x4*)(sp + voff);
        *(LAS u32x4*)(lds + LDS_KIMG + row * VRS + ch * 16) = kv;
        *(LAS u32x4*)(lds + LDS_VIMG + row * VRS + ch * 16) = vv;
    }
}
__device__ __forceinline__ void gate_load(const bf16_t* grow  , int hi, u32x2 (&gv)[2][4]) {
#pragma unroll
    for (int dh = 0; dh < 2; ++dh)
#pragma unroll
        for (int g = 0; g < 4; ++g) gv[dh][g] = *(const u32x2*)(grow + 32 * dh + 8 * g + 4 * hi);
}
__device__ __forceinline__ void gate_store(const f32x16 (&o)[2], float rscale, const u32x2 (&gv)[2][4], bf16_t* yrow  , int hi) {
#pragma unroll
    for (int dh = 0; dh < 2; ++dh)
#pragma unroll
        for (int g = 0; g < 4; ++g) {
            const int d = 32 * dh + 8 * g + 4 * hi;
            const u32x2 gg = gv[dh][g];
            const float y0 = o[dh][4 * g + 0] * rscale * bflo(gg.x), y1 = o[dh][4 * g + 1] * rscale * bfhi(gg.x);
            const float y2 = o[dh][4 * g + 2] * rscale * bflo(gg.y), y3 = o[dh][4 * g + 3] * rscale * bfhi(gg.y);
            u32x2 w; w.x = pk2(y0, y1); w.y = pk2(y2, y3);
            *(u32x2*)(yrow + d) = w;
        }
}

__device__ __forceinline__ void sb_deal(int r, int nround, int bi, int& bh, int& QB) {
    const int k = r < nround ? r : 2 + ((bi - 32) >> 5), iv = r < nround ? bi : ((bi - 32) & 31);
    const int x = iv & 7, j = iv >> 3; bh = k * 16 + x * 2 + (j >> 4); QB = 15 - (j & 15);
}
template <bool DIAG> __device__ __forceinline__ bool sb_step(const bf16x8 (&kc)[4], LAS unsigned char* vt, const bf16x8 (&qf)[4], f32x16 (&o)[2], float& Rl, int lane) {
    const int r32 = lane & 31, hi = lane >> 5;
    f32x16 z, z1;
#pragma unroll
    for (int i = 0; i < 16; ++i) { z[i] = 0.f; z1[i] = 0.f; }
    __builtin_amdgcn_s_setprio(1);
    z  = __builtin_amdgcn_mfma_f32_32x32x16_bf16(kc[0], qf[0], z, 0, 0, 0);
    z1 = __builtin_amdgcn_mfma_f32_32x32x16_bf16(kc[1], qf[1], z1, 0, 0, 0);
    z  = __builtin_amdgcn_mfma_f32_32x32x16_bf16(kc[2], qf[2], z, 0, 0, 0);
    z1 = __builtin_amdgcn_mfma_f32_32x32x16_bf16(kc[3], qf[3], z1, 0, 0, 0);
    __builtin_amdgcn_s_setprio(0);
#pragma unroll
    for (int i = 0; i < 16; ++i) z[i] += z1[i];
    float be[16], fl[16];
#pragma unroll
    for (int r = 0; r < 16; ++r) {
        const float zc = __builtin_amdgcn_fmed3f(z[r], -100.f, 100.f);
        const float e = ex2(-zc);
        const float rc = __builtin_amdgcn_rcpf(1.f + e);
        const bool valid = !DIAG || (crow(r, hi) < r32);
        be[r] = valid ? rc : 0.f;
        fl[r] = valid ? e * rc : 1.f;
    }
    float gp[4], pg[4];
#pragma unroll
    for (int g = 0; g < 4; ++g) { gp[g] = (fl[4 * g] * fl[4 * g + 1]) * (fl[4 * g + 2] * fl[4 * g + 3]); pg[g] = xor32(gp[g], hi); }
    float acc = Rl; float w[16];
#pragma unroll
    for (int g = 3; g >= 0; --g) {
        const float l3 = hi ? acc : acc * pg[g];
        const float l2 = l3 * fl[4 * g + 3], l1 = l2 * fl[4 * g + 2], l0 = l1 * fl[4 * g + 1];
        w[4 * g + 3] = be[4 * g + 3] * l3; w[4 * g + 2] = be[4 * g + 2] * l2; w[4 * g + 1] = be[4 * g + 1] * l1; w[4 * g + 0] = be[4 * g + 0] * l0;
        acc *= gp[g] * pg[g];
    }
    Rl = acc;
    bf16x8 pw[2];
#pragma unroll
    for (int s = 0; s < 2; ++s) { u32x4 t; t.x = pk2(w[8 * s], w[8 * s + 1]); t.y = pk2(w[8 * s + 2], w[8 * s + 3]); t.z = pk2(w[8 * s + 4], w[8 * s + 5]); t.w = pk2(w[8 * s + 6], w[8 * s + 7]); pw[s] = __builtin_bit_cast(bf16x8, t); }
    pv_tile(vt, lane, pw, o);
    return __all(Rl < 1.17549435e-38f);
}
__device__ __forceinline__ void sb_issue(int b, int h, int QB, const bf16_t* P, int tid, u32x4 (&pk)[4], u32x4 (&pv)[4]) {
    const bf16_t* src = P + ((size_t)b * SEQ + (size_t)QB * 256) * DIN + C_SBK + h * 64;
#pragma unroll
    for (int i = 0; i < 4; ++i) { const int idx = tid + i * 512; const bf16_t* sp = src + (size_t)(idx >> 3) * DIN + (idx & 7) * 8; pk[i] = *(const u32x4*)sp; pv[i] = *(const u32x4*)(sp + (C_SBV - C_SBK)); }
}
__device__ __forceinline__ void sb_block(int b, int h, int QB, const bf16_t* P, bf16_t* Y, LAS unsigned char* lds, int wave, int lane, int tid, u32x4 (&pk)[4], u32x4 (&pv)[4], bool has_next, int bn, int hn, int QBn) {
    asm volatile("" : "+v"(lane), "+v"(tid));
    const int r32 = lane & 31, hi = lane >> 5;
    const int t_hi = QB * 8 + 7, t_lo = QB * 8;
    const bf16_t* kbase = P + (size_t)b * SEQ * DIN + C_SBK + h * 64;
#pragma unroll
    for (int i = 0; i < 4; ++i) { const int idx = tid + i * 512, row = idx >> 3, ch = idx & 7;
        *(LAS u32x4*)(lds + LDS_KIMG + row * VRS + ch * 16) = pk[i]; *(LAS u32x4*)(lds + LDS_VIMG + row * VRS + ch * 16) = pv[i]; }
    const int qt = QB * 8 + wave;
    const size_t rowq = (size_t)b * SEQ + (size_t)qt * 32;
    bf16x8 qf[4];
    ld_frag(P + (rowq + r32) * DIN + C_SBQ + h * 64 + 8 * hi, qf);
    u32x2 gv[2][4];
    gate_load(P + (rowq + r32) * DIN + C_SBG + h * 64, hi, gv);
    f32x16 o[2];
#pragma unroll
    for (int i = 0; i < 16; ++i) { o[0][i] = 0.f; o[1][i] = 0.f; }
    float Rl = 1.f;
    __syncthreads();
    if (has_next) sb_issue(bn, hn, QBn, P, tid, pk, pv);
    int kt = qt - 1;
    { bf16x8 kc[4];
      lds_frag(lds + LDS_KIMG + (qt - t_lo) * TILE_B, lane, kc);
      if (sb_step<true>(kc, lds + LDS_VIMG + (qt - t_lo) * TILE_B, qf, o, Rl, lane)) kt = -1; }
    for (; kt >= t_lo; --kt) {
        bf16x8 kc[4];
        lds_frag(lds + LDS_KIMG + (kt - t_lo) * TILE_B, lane, kc);
        if (sb_step<false>(kc, lds + LDS_VIMG + (kt - t_lo) * TILE_B, qf, o, Rl, lane)) { kt = -1; break; }
    }
    LAS unsigned char* wt = lds + LDS_WTILE + wave * TILE_B;
    for (; kt >= 0; --kt) {
        const bf16_t* kp = kbase + ((size_t)kt * 32 + r32) * DIN + 8 * hi;
        bf16x8 kc[4], vc[4];
        ld_frag(kp, kc); ld_frag(kp + (C_SBV - C_SBK), vc);
#pragma unroll
        for (int d0 = 0; d0 < 4; ++d0) *(LAS bf16x8*)(wt + r32 * VRS + 32 * d0 + 16 * hi) = vc[d0];
        asm volatile("s_waitcnt lgkmcnt(0)" ::: "memory");
        if (sb_step<false>(kc, wt, qf, o, Rl, lane)) break;
        asm volatile("s_waitcnt lgkmcnt(0)" ::: "memory");
    }
    gate_store(o, 1.f, gv, Y + (rowq + r32) * DM + h * 64, hi);
    __syncthreads();
}

__device__ __forceinline__ void xa_block(int b, int h, int QB, const bf16_t* P, const bf16_t* KV, bf16_t* Y, LAS unsigned char* lds, int wave, int lane, int tid) {
    asm volatile("" : "+v"(lane), "+v"(tid));
    const int r32 = lane & 31, hi = lane >> 5;
    stage_kv(KV + (size_t)b * NMEM * 512 + h * 64, 512, 256, NMEM, lds, tid);
    __syncthreads();
#pragma unroll 1
    for (int j = 0; j < 2; ++j) {
        const size_t rowq = (size_t)b * SEQ + (size_t)QB * 512 + (size_t)(wave * 2 + j) * 32;
        bf16x8 qf[4];
        ld_frag(P + (rowq + r32) * DIN + C_XQ + h * 64 + 8 * hi, qf);
        u32x2 gv[2][4];
        gate_load(P + (rowq + r32) * DIN + C_XG + h * 64, hi, gv);
        f32x16 o[2];
#pragma unroll
        for (int i = 0; i < 16; ++i) { o[0][i] = 0.f; o[1][i] = 0.f; }
        float mrun = -1e30f, lsum = 0.f;
#pragma unroll 2
        for (int kt = 0; kt < NMEM / 32; ++kt) {
            bf16x8 kc[4];
            lds_frag(lds + LDS_KIMG + kt * TILE_B, lane, kc);
            f32x16 s;
#pragma unroll
            for (int i = 0; i < 16; ++i) s[i] = 0.f;
            __builtin_amdgcn_s_setprio(1);
#pragma unroll
            for (int d0 = 0; d0 < 4; ++d0) s = __builtin_amdgcn_mfma_f32_32x32x16_bf16(kc[d0], qf[d0], s, 0, 0, 0);
            __builtin_amdgcn_s_setprio(0);
            float mx = s[0];
#pragma unroll
            for (int r = 1; r < 16; ++r) mx = fmaxf(mx, s[r]);
            mx = fmaxf(mx, xor32(mx, hi));
            if (__any(mx > mrun + 8.f)) {
                const float mnew = fmaxf(mrun, mx), alpha = ex2(mrun - mnew);
                mrun = mnew; lsum *= alpha;
#pragma unroll
                for (int i = 0; i < 16; ++i) { o[0][i] *= alpha; o[1][i] *= alpha; }
            }
            float w[16], ps = 0.f;
#pragma unroll
            for (int r = 0; r < 16; ++r) { w[r] = ex2(s[r] - mrun); ps += w[r]; }
            lsum += ps;
            bf16x8 pw[2];
#pragma unroll
            for (int t2 = 0; t2 < 2; ++t2) { u32x4 t; t.x = pk2(w[8 * t2], w[8 * t2 + 1]); t.y = pk2(w[8 * t2 + 2], w[8 * t2 + 3]); t.z = pk2(w[8 * t2 + 4], w[8 * t2 + 5]); t.w = pk2(w[8 * t2 + 6], w[8 * t2 + 7]); pw[t2] = __builtin_bit_cast(bf16x8, t); }
            pv_tile(lds + LDS_VIMG + kt * TILE_B, lane, pw, o);
        }
        lsum += xor32(lsum, hi);
        gate_store(o, 1.f / lsum, gv, Y + (rowq + r32) * DM + 768 + h * 64, hi);
    }
    __syncthreads();
}

constexpr int XLS = 68;
__device__ __forceinline__ void lru_stage_a(int b, int n, int c, const bf16_t* P, const bf16_t* WG  , const float* conv_w, const float* conv_b,
                                            const float* b_rg, const float* b_ig, const float* lam, float* PH  , LAS unsigned char* wl, int lane,
                                            float (&av)[2][2][16], unsigned (&up)[2][2][8]) {
    asm volatile("" : "+v"(lane));
    LAS float* xl = (LAS float*)wl;
    float brg[2], big[2], cl[2], hc[2], cc[2];
    { const int r32 = lane & 31;
#pragma unroll
      for (int eh = 0; eh < 2; ++eh) {
        const int ch = n * 64 + 32 * eh + r32;
        brg[eh] = b_rg[ch]; big[eh] = b_ig[ch];
        const float nl = -lam[ch];
        const float spn = fmaxf(nl, 0.f) + log1pf(__expf(-fabsf(nl)));
        cl[eh] = -8.f * spn;
        hc[eh] = 0.f; cc[eh] = 1.f;
      } }
#pragma unroll
    for (int tile = 0; tile < CHUNK / 32; ++tile) {
        int ln = lane; asm volatile("" : "+v"(ln));
        const int r32 = ln & 31, hi = ln >> 5;
        const int t0 = c * CHUNK + tile * 32;
        bf16x8 xa[4];
#pragma unroll
        for (int d0 = 0; d0 < 4; ++d0) {
            const int chb = n * 64 + 16 * d0 + 8 * hi;
            float a8[8];
            { const f32x4 b0 = *(const f32x4*)(conv_b + chb), b1 = *(const f32x4*)(conv_b + chb + 4);
              a8[0] = b0.x; a8[1] = b0.y; a8[2] = b0.z; a8[3] = b0.w; a8[4] = b1.x; a8[5] = b1.y; a8[6] = b1.z; a8[7] = b1.w; }
#pragma unroll
            for (int tap = 0; tap < 4; ++tap) {
                const int tt = t0 + r32 - 3 + tap;
                u32x4 xr = (u32x4){0u, 0u, 0u, 0u};
                if (tt >= 0) xr = *(const u32x4*)(P + ((size_t)b * SEQ + tt) * DIN + C_LX + chb);
                const f32x4 w0 = *(const f32x4*)(conv_w + tap * LRU_W + chb), w1 = *(const f32x4*)(conv_w + tap * LRU_W + chb + 4);
                a8[0] += w0.x * bflo(xr.x); a8[1] += w0.y * bfhi(xr.x); a8[2] += w0.z * bflo(xr.y); a8[3] += w0.w * bfhi(xr.y);
                a8[4] += w1.x * bflo(xr.z); a8[5] += w1.y * bfhi(xr.z); a8[6] += w1.z * bflo(xr.w); a8[7] += w1.w * bfhi(xr.w);
            }
            u32x4 t; t.x = pk2(a8[0], a8[1]); t.y = pk2(a8[2], a8[3]); t.z = pk2(a8[4], a8[5]); t.w = pk2(a8[6], a8[7]);
            xa[d0] = __builtin_bit_cast(bf16x8, t);
            *(LAS f32x4*)(xl + r32 * XLS + 16 * d0 + 8 * hi) = (f32x4){a8[0], a8[1], a8[2], a8[3]};
            *(LAS f32x4*)(xl + r32 * XLS + 16 * d0 + 8 * hi + 4) = (f32x4){a8[4], a8[5], a8[6], a8[7]};
        }
        asm volatile("s_waitcnt lgkmcnt(0)" ::: "memory");
#pragma unroll
        for (int eh = 0; eh < 2; ++eh) {
            float uvt[16];
            f32x16 Rg, Ig;
#pragma unroll
            for (int i = 0; i < 16; ++i) { Rg[i] = 0.f; Ig[i] = 0.f; }
            { bf16x8 wr[4], wi[4];
#pragma unroll
              for (int d0 = 0; d0 < 4; ++d0) {
                  wr[d0] = *(const bf16x8*)(WG + ((size_t)(n * 2 + 0) * 64 + 32 * eh + r32) * 64 + 16 * d0 + 8 * hi);
                  wi[d0] = *(const bf16x8*)(WG + ((size_t)(n * 2 + 1) * 64 + 32 * eh + r32) * 64 + 16 * d0 + 8 * hi);
              }
#pragma unroll
              for (int d0 = 0; d0 < 4; ++d0) { Rg = __builtin_amdgcn_mfma_f32_32x32x16_bf16(xa[d0], wr[d0], Rg, 0, 0, 0); Ig = __builtin_amdgcn_mfma_f32_32x32x16_bf16(xa[d0], wi[d0], Ig, 0, 0, 0); } }
#pragma unroll
            for (int r = 0; r < 16; ++r) {
                const float xv = xl[crow(r, hi) * XLS + 32 * eh + r32];
                const float rg = sigm(Rg[r] + brg[eh]), ig = sigm(Ig[r] + big[eh]);
                const float la = cl[eh] * rg;
                const float a = ex2(la * LOG2E);
                const float x2 = 2.f * la;
                const float poly = -x2 * (1.f + x2 * (0.5f + x2 * (0.16666667f + x2 * (0.041666668f + x2 * (0.008333334f + x2 * 0.0013888889f)))));
                const float om = (x2 > -0.3f) ? poly : 1.f - a * a;
                av[tile][eh][r] = a; uvt[r] = __builtin_amdgcn_sqrtf(om) * ig * xv;
            }
#pragma unroll
            for (int r = 0; r < 8; ++r) up[tile][eh][r] = pk2(uvt[2 * r], uvt[2 * r + 1]);
            float s = hc[eh], cs = cc[eh];
#pragma unroll
            for (int g = 0; g < 4; ++g) {
                float A = av[tile][eh][4 * g], U = uvt[4 * g];
#pragma unroll
                for (int k = 1; k < 4; ++k) { U = av[tile][eh][4 * g + k] * U + uvt[4 * g + k]; A *= av[tile][eh][4 * g + k]; }
                const float pA = xor32(A, hi), pU = xor32(U, hi);
                const float loA = hi ? pA : A, loU = hi ? pU : U, hiA = hi ? A : pA, hiU = hi ? U : pU;
                s = loA * s + loU; cs = loA * cs;
                s = hiA * s + hiU; cs = hiA * cs;
            }
            hc[eh] = s; cc[eh] = cs;
#pragma unroll
            for (int r = 0; r < 8; ++r) asm volatile("" : "+v"(up[tile][eh][r]));
            __builtin_amdgcn_sched_barrier(0);
        }
        asm volatile("s_waitcnt lgkmcnt(0)" ::: "memory");
    }
    if ((lane >> 5) == 0) {
#pragma unroll
        for (int eh = 0; eh < 2; ++eh) {
            const int ch = n * 64 + 32 * eh + (lane & 31);
            PH[((size_t)b * NCHUNK + c) * LRU_W + ch] = cc[eh];
            PH[(size_t)BATCH * NCHUNK * LRU_W + ((size_t)b * NCHUNK + c) * LRU_W + ch] = hc[eh];
        }
    }
}
__device__ __forceinline__ void lru_stage_b(int b, int n, int c, const bf16_t* P, const float* PH, bf16_t* Y, LAS unsigned char* wl, int lane, const float (&av)[2][2][16], const unsigned (&up)[2][2][8]) {
    asm volatile("" : "+v"(lane));
    const int r32 = lane & 31, hi = lane >> 5;
    LAS float* xl = (LAS float*)wl;
    float hc[2] = {0.f, 0.f};
    if (c > 0) {
        const float* pa0 = PH + (size_t)b * NCHUNK * LRU_W + n * 64 + r32; const float* ph0 = pa0 + (size_t)BATCH * NCHUNK * LRU_W;
        const int mid = (c + 1) >> 1, lo_ = hi ? mid : 0, hi_ = hi ? c : mid;
        float A[2] = {1.f, 1.f}, U[2] = {0.f, 0.f};
        for (int c0 = lo_; c0 < hi_; c0 += 16) {
            float pv[2][16], hv[2][16];
#pragma unroll
            for (int j = 0; j < 16; ++j) { const int cp = c0 + j < hi_ ? c0 + j : c0;
#pragma unroll
                for (int eh = 0; eh < 2; ++eh) { pv[eh][j] = pa0[cp * LRU_W + 32 * eh]; hv[eh][j] = ph0[cp * LRU_W + 32 * eh]; } }
#pragma unroll
            for (int j = 0; j < 16; ++j) if (c0 + j < hi_) {
#pragma unroll
                for (int eh = 0; eh < 2; ++eh) { U[eh] = pv[eh][j] * U[eh] + hv[eh][j]; A[eh] *= pv[eh][j]; } }
        }
#pragma unroll
        for (int eh = 0; eh < 2; ++eh) {
            const float Uo = xor32(U[eh], hi), Ao = xor32(A[eh], hi);
            hc[eh] = hi ? A[eh] * Uo + U[eh] : Ao * U[eh] + Uo;
        }
    }
#pragma unroll
    for (int tile = 0; tile < CHUNK / 32; ++tile) {
        const size_t row0 = (size_t)b * SEQ + (size_t)c * CHUNK + tile * 32;
#pragma unroll
        for (int eh = 0; eh < 2; ++eh) {
            float uvt[16];
#pragma unroll
            for (int r = 0; r < 8; ++r) { uvt[2 * r] = bflo(up[tile][eh][r]); uvt[2 * r + 1] = bfhi(up[tile][eh][r]); }
            float Ag[4], Ug[4], pA[4], pU[4];
#pragma unroll
            for (int g = 0; g < 4; ++g) {
                float A = av[tile][eh][4 * g], U = uvt[4 * g];
#pragma unroll
                for (int k = 1; k < 4; ++k) { U = av[tile][eh][4 * g + k] * U + uvt[4 * g + k]; A *= av[tile][eh][4 * g + k]; }
                Ag[g] = A; Ug[g] = U; pA[g] = xor32(A, hi); pU[g] = xor32(U, hi);
            }
            float s = hc[eh];
#pragma unroll
            for (int g = 0; g < 4; ++g) {
                const float loA = hi ? pA[g] : Ag[g], loU = hi ? pU[g] : Ug[g], hiA = hi ? Ag[g] : pA[g], hiU = hi ? Ug[g] : pU[g];
                const float in_lo = s;
                s = loA * s + loU;
                const float in_hi = s;
                s = hiA * s + hiU;
                float hh = hi ? in_hi : in_lo;
#pragma unroll
                for (int k = 0; k < 4; ++k) { const int r = 4 * g + k; hh = av[tile][eh][r] * hh + uvt[r]; xl[crow(r, hi) * XLS + 32 * eh + r32] = hh; }
            }
            hc[eh] = s;
        }
        asm volatile("s_waitcnt lgkmcnt(0)" ::: "memory");
#pragma unroll
        for (int d0 = 0; d0 < 4; ++d0) {
            const int cb = 16 * d0 + 8 * hi;
            const f32x4 h0 = *(LAS f32x4*)(xl + r32 * XLS + cb), h1 = *(LAS f32x4*)(xl + r32 * XLS + cb + 4);
            const u32x4 gv = *(const u32x4*)(P + (row0 + r32) * DIN + C_LG + n * 64 + cb);
            u32x4 w;
            w.x = pk2(h0.x * bflo(gv.x), h0.y * bfhi(gv.x)); w.y = pk2(h0.z * bflo(gv.y), h0.w * bfhi(gv.y));
            w.z = pk2(h1.x * bflo(gv.z), h1.y * bfhi(gv.z)); w.w = pk2(h1.z * bflo(gv.w), h1.w * bfhi(gv.w));
            *(u32x4*)(Y + (row0 + r32) * DM + 512 + n * 64 + cb) = w;
        }
        asm volatile("s_waitcnt lgkmcnt(0)" ::: "memory");
    }
}

#define RLX_AGENT __ATOMIC_RELAXED, __HIP_MEMORY_SCOPE_AGENT
#define LDS_WAIT() asm volatile("s_waitcnt lgkmcnt(0)" ::: "memory")
#define VM_WAIT() asm volatile("s_waitcnt vmcnt(0)" ::: "memory")
#define XB_TMO      128
#define XB_XCNT(j)  (256  + 64 * (j))
#define XB_XSUB(j)  (1280 + 64 * (j))
#define XB_XGEN(j)  (2304 + 64 * (j))
#define XB_TOP      3328
#define XB_TOPGEN   3392
#define XCD_BAR_WORDS 3456
#define XB_SPIN_CAP (1u << 18)

__device__ __forceinline__ unsigned xb_ld(unsigned* p)              { return __hip_atomic_load(p, __ATOMIC_RELAXED, __HIP_MEMORY_SCOPE_AGENT); }
__device__ __forceinline__ unsigned xb_add(unsigned* p, unsigned v) { return __hip_atomic_fetch_add(p, v, __ATOMIC_RELAXED, __HIP_MEMORY_SCOPE_AGENT); }
__device__ __forceinline__ unsigned xb_xcc_id() { return (unsigned)__builtin_amdgcn_s_getreg((3 << 11) | 20) & 0xFu; }
#define XB_SPIN(cond, bar) do { unsigned _sp = 0; while (cond) { __builtin_amdgcn_s_sleep(1); \
    if ((++_sp & 255u) == 0u) { if (xb_ld(&(bar)[XB_TMO])) break; if (_sp > XB_SPIN_CAP) { atomicAdd(&(bar)[XB_TMO], 1u); break; } } } } while (0)

struct XcdBarrier {
    unsigned* bar; unsigned x;
    volatile LAS unsigned* st;
};

__device__ __forceinline__ XcdBarrier xcd_barrier_post(unsigned* bar, volatile LAS unsigned* st) {
    XcdBarrier b; b.bar = bar; b.x = xb_xcc_id(); b.st = st;
    if (threadIdx.x == 0) (void)xb_add(&bar[XB_XCNT(b.x)], 1u);
    return b;
}
__device__ __forceinline__ void xcd_barrier_complete(unsigned* bar, unsigned x, unsigned& nloc, unsigned& nx) {
    const unsigned G = gridDim.x * gridDim.y * gridDim.z;
    unsigned sum, cnt, mine, sp = 0u;
    for (;;) {
        sum = 0u; cnt = 0u; mine = 0u;
#pragma unroll
        for (unsigned j = 0; j < 16; ++j) { const unsigned c = xb_ld(&bar[XB_XCNT(j)]); sum += c; cnt += (c > 0u) ? 1u : 0u; mine = (j == x) ? c : mine; }
        if (sum == G) break;
        __builtin_amdgcn_s_sleep(1);
        if ((++sp & 255u) == 0u) { if (xb_ld(&bar[XB_TMO])) break; if (sp > XB_SPIN_CAP) { atomicAdd(&bar[XB_TMO], 1u); break; } }
    }
    nloc = mine > 0u ? mine : 1u; nx = cnt > 0u ? cnt : 1u;
}

__device__ __forceinline__ void xcd_barrier(const XcdBarrier& b) {
    asm volatile("s_waitcnt vmcnt(0)" ::: "memory");
    __syncthreads();
    if (threadIdx.x == 0) {
        unsigned* bar = b.bar;
        __builtin_amdgcn_s_waitcnt(0);
        unsigned nloc = b.st[0], nx = b.st[1];
        if (nloc == 0u) { xcd_barrier_complete(bar, b.x, nloc, nx); b.st[0] = nloc; b.st[1] = nx; }
        const unsigned old = xb_add(&bar[XB_XSUB(b.x)], 1u);
        const unsigned gen = old / nloc;
        if (old + 1u == (gen + 1u) * nloc) {
            __builtin_amdgcn_fence(__ATOMIC_RELEASE, "agent");
            asm volatile("s_waitcnt vmcnt(0)" ::: "memory");
            const unsigned og = xb_add(&bar[XB_TOP], 1u);
            const unsigned tg = og / nx;
            if (og + 1u == (tg + 1u) * nx) xb_add(&bar[XB_TOPGEN], 1u);
            else XB_SPIN(xb_ld(&bar[XB_TOPGEN]) == tg, bar);
            __builtin_amdgcn_fence(__ATOMIC_ACQUIRE, "agent");
            xb_add(&bar[XB_XGEN(b.x)], 1u);
            asm volatile("s_waitcnt vmcnt(0)" ::: "memory");
        } else {
            XB_SPIN(xb_ld(&bar[XB_XGEN(b.x)]) == gen, bar);
            __builtin_amdgcn_fence(__ATOMIC_ACQUIRE, "agent");
            asm volatile("s_waitcnt vmcnt(0)" ::: "memory");
        }
    }
    __syncthreads();
}

struct Args { const float* in[18]; float* out; unsigned char* ws; int ph_lo, ph_hi, dup, pad; };
constexpr int LDS_BYTES = LDS_MISC + 256;
constexpr int N_PHASES = 9;

__global__ void __launch_bounds__(512, 2) hymba_fwd(Args a) {
    extern __shared__ __attribute__((aligned(16))) unsigned char lds_raw[];
    LAS unsigned char* lds = (LAS unsigned char*)lds_raw;
    cg::grid_group grid = cg::this_grid();
    const int tid = threadIdx.x, lane = tid & 63, wave = __builtin_amdgcn_readfirstlane(tid >> 6);
    const int G = gridDim.x, gw = blockIdx.x * 8 + wave, NGW = G * 8;
    unsigned char* ws = a.ws;
    const float* x_in = a.in[0]; const float* mem = a.in[1];
    bf16_t* WIN0 = (bf16_t*)(ws + WS_WIN0); bf16_t* WIN1 = (bf16_t*)(ws + WS_WIN1); bf16_t* WOUT = (bf16_t*)(ws + WS_WOUT); bf16_t* WGT = (bf16_t*)(ws + WS_WG);
    float* SS = (float*)(ws + WS_SS); float* MRS = (float*)(ws + WS_MRS); float* PHB = (float*)(ws + WS_PH);
    bf16_t* KV = (bf16_t*)(ws + WS_KV); bf16_t* XB = (bf16_t*)(ws + WS_XB); bf16_t* PROJ = (bf16_t*)(ws + WS_PROJ); bf16_t* Y = (bf16_t*)(ws + WS_Y);
    LAS unsigned char* wl = lds + wave * 18432;
    volatile LAS unsigned* MISC = (volatile LAS unsigned*)(lds + LDS_MISC);
    if (tid < 64) MISC[tid] = 0u;
    __syncthreads();
    unsigned* barw = (unsigned*)(ws + WS_BAR);
    const XcdBarrier bar = xcd_barrier_post(barw, MISC);
    if (a.dup & 256) grid.sync();
#define RUN(k) (a.ph_lo <= (k) && (k) < a.ph_hi)
#define REPS(bit) (1 + ((a.dup >> (bit)) & 1))
#define SEAM(k) do { if (RUN(k) && RUN((k) + 1)) { xcd_barrier(bar); if (a.dup & 128) { xcd_barrier(bar); xcd_barrier(bar); } } } while (0)

    if (RUN(0)) {
#pragma unroll 1
      for (int rep = 0; rep < REPS(0); ++rep) {
        int lane0 = lane; asm volatile("" : "+v"(lane0));
        LAS float* scr = (LAS float*)wl;
        constexpr int I_IN = 16 * 48, I_OUT = 16 * 16, I_KV = 16 * 8, I_G = 16;
        constexpr int NITEMS = 2 * (I_IN + I_OUT + I_KV) + I_G;
        for (int it = (gw + NGW / 2) % NGW; it < NITEMS; it += NGW) {
            int r = it;
            if (r < 2 * I_IN) { const int l = r / I_IN; p0_transpose_item(a.in[3] + (size_t)l * DM * DIN, DM, DIN, l ? WIN1 : WIN0, 0, a.in[2] + l * DM, true, scr, r % I_IN, lane); }
            else if ((r -= 2 * I_IN) < 2 * I_OUT) { const int l = r / I_OUT; p0_transpose_item(a.in[17] + (size_t)l * DM * DM, DM, DM, WOUT + (size_t)l * DM * DM, 0, nullptr, false, scr, r % I_OUT, lane); }
            else if ((r -= 2 * I_OUT) < 2 * I_KV) { const int l = r / I_KV; p0_transpose_item(a.in[16] + (size_t)l * DM * 512, DM, 512, WIN0, 3072 + 512 * l, a.in[15] + l * DM, true, scr, r % I_KV, lane); }
            else { r -= 2 * I_KV; const int l = r >> 3, n = (r >> 1) & 3, kind = r & 1;
              p0_transpose_item(a.in[kind ? 10 : 8] + (size_t)(l * 4 + n) * 4096, 64, 64, WGT + (size_t)((l * 4 + n) * 2 + kind) * 4096, 0, nullptr, false, scr, 0, lane); }
        }
        for (int m4 = gw * 4; m4 < MTOK + MMEM; m4 += NGW * 4) {
          if (m4 < MTOK + MMEM) {
            f32x4 v[4][4]; float sq[4];
#pragma unroll
            for (int q = 0; q < 4; ++q) {
                const int m = m4 + q;
                const float* src = m < MTOK ? x_in + (size_t)m * DM : mem + (size_t)(m - MTOK) * DM;
                const f32x4* xr = (const f32x4*)src + lane;
#pragma unroll
                for (int j = 0; j < 4; ++j) v[q][j] = xr[64 * j];
            }
#pragma unroll
            for (int q = 0; q < 4; ++q) {
                float s = 0.f;
#pragma unroll
                for (int j = 0; j < 4; ++j) s += (v[q][j].x * v[q][j].x + v[q][j].y * v[q][j].y) + (v[q][j].z * v[q][j].z + v[q][j].w * v[q][j].w);
                sq[q] = s;
            }
#pragma unroll
            for (int o = 1; o < 64; o <<= 1) {
#pragma unroll
                for (int q = 0; q < 4; ++q) sq[q] += __shfl_xor(sq[q], o);
            }
#pragma unroll
            for (int q = 0; q < 4; ++q) {
                const int m = m4 + q;
                u32x2* o8 = (u32x2*)(XB + (size_t)m * DM) + lane;
#pragma unroll
                for (int j = 0; j < 4; ++j) { u32x2 w; w.x = pk2(v[q][j].x, v[q][j].y); w.y = pk2(v[q][j].z, v[q][j].w); o8[64 * j] = w; }
                if (m < MTOK) { if (lane < 16) SS[(size_t)m * 16 + lane] = lane == 0 ? sq[q] : 0.f; }
                else if (lane == 0) MRS[m - MTOK] = rsqrtf(sq[q] * (1.f / 1024.f) + EPS);
            }
        }
        }
      }
    }
    SEAM(0);

#pragma unroll 1
    for (int l = 0; l < 2; ++l) {
        const int pb = 1 + 4 * l;
        if (RUN(pb)) {
            pg8::Gemm g{XB, l ? WIN1 : WIN0, MTOK, DIN, DM};
            ProjOrder S; S.init(G, (int)blockIdx.x, 0);
            EpiProj E{PROJ, KV, SS, MRS, a.in[4] + l * 64, a.in[5] + l * 64, a.in[13] + l * 64, a.in[14]};
#pragma unroll 1
            for (int rep = 0; rep < REPS(1); ++rep) pg8::gemm_phase<EpiProj, ProjOrder, true, true>(lds, g, S, E);
        }
        SEAM(pb);
        {
            constexpr int U_XA = BATCH * 4 * 8;
            const int bi = (int)blockIdx.x;
            if (l == 0) {
                pg8::Gemm g{XB, WIN0, MTOK, DIN, DM};
                ProjOrder S; S.so.init(MTOK, DIN, G, bi); S.so.nwg = 0; S.extra = 32;
                EpiProj E{PROJ, KV, SS, MRS, a.in[4], a.in[5], a.in[13], a.in[14]};
                pg8::gemm_phase<EpiProj, ProjOrder, true, true>(lds, g, S, E);
            }
            const int nround = (l == 0 && bi < 32) ? 2 : 4, norph = (l == 0 && bi >= 32 && bi < 96) ? 1 : 0;
            {
                u32x4 pk[4], pv[4];
                int tid2 = tid; asm volatile("" : "+v"(tid2));
                int bh, QB; sb_deal(0, nround, bi, bh, QB);
                sb_issue(bh >> 3, bh & 7, QB, PROJ, tid2, pk, pv);
#pragma unroll 1
                for (int r = 0; r < nround + norph; ++r) {
                    int bhn = 0, QBn = 0; const bool has_next = r + 1 < nround + norph;
                    if (has_next) sb_deal(r + 1, nround, bi, bhn, QBn);
                    sb_block(bh >> 3, bh & 7, QB, PROJ, Y, lds, wave, lane, tid2, pk, pv, has_next, bhn >> 3, bhn & 7, QBn);
                    bh = bhn; QB = QBn;
                }
            }
            const int c = gw % NCHUNK, n = (gw / NCHUNK) & 3, b = gw / (NCHUNK * 4);
            float av[2][2][16]; unsigned up[2][2][8];
            lru_stage_a(b, n, c, PROJ, WGT + (size_t)l * 8 * 4096, a.in[6] + (size_t)l * 4 * LRU_W, a.in[7] + l * LRU_W, a.in[9] + l * LRU_W, a.in[11] + l * LRU_W, a.in[12] + l * LRU_W,
                        PHB + (size_t)l * 2 * BATCH * NCHUNK * LRU_W, wl, lane, av, up);
            xcd_barrier(bar);
            lru_stage_b(b, n, c, PROJ, PHB + (size_t)l * 2 * BATCH * NCHUNK * LRU_W, Y, wl, lane, av, up);
            __syncthreads();
#pragma unroll 1
            for (int v = bi; v < U_XA; v += G) {
                const int QB = v & 7, h = (v >> 3) & 3, bx = v >> 5;
                xa_block(bx, h, QB, PROJ, KV + (size_t)l * MMEM * 512, Y, lds, wave, lane, tid);
            }
        }
        xcd_barrier(bar);
        if (RUN(pb + 3)) {
            pg8::Gemm g{Y, WOUT + (size_t)l * DM * DM, MTOK, DM, DM};
            ProjOrder S; S.so.init(MTOK, DM, G, (int)blockIdx.x); S.extra = 0;
            EpiOut E{x_in, XB, a.out, l ? nullptr : XB, l ? nullptr : SS};
#pragma unroll 1
            for (int rep = 0; rep < (l ? 1 : REPS(6)); ++rep) pg8::gemm_phase<EpiOut, ProjOrder, true, true>(lds, g, S, E);
        }
        if (l == 0) SEAM(pb + 3);
    }
#undef RUN
#undef REPS
#undef SEAM
}

#ifndef DUP_MASK
#define DUP_MASK 0
#endif
#ifndef N_LAUNCH_SPLIT
#define N_LAUNCH_SPLIT 0
#endif
extern "C" void kernel_launch(void* const* d_in, const int* in_sizes, int n_in, void* d_out, int out_size, void* d_ws, size_t ws_size, hipStream_t stream) {
    static int grid = 0;
    if (grid == 0) {
        if (n_in != 18 || out_size != MTOK * DM || ws_size < WS_END) { fprintf(stderr, "kernel_launch: unexpected shapes (n_in %d out %d ws %zu)\n", n_in, out_size, ws_size); grid = -1; return; }
        int dev = 0, cus = 0, per_cu = 0;
        hipGetDevice(&dev); hipDeviceGetAttribute(&cus, hipDeviceAttributeMultiprocessorCount, dev);
        if (hipFuncSetAttribute((const void*)hymba_fwd, hipFuncAttributeMaxDynamicSharedMemorySize, LDS_BYTES) != hipSuccess) { fprintf(stderr, "kernel_launch: hipFuncSetAttribute failed\n"); }
        if (hipOccupancyMaxActiveBlocksPerMultiprocessor(&per_cu, (const void*)hymba_fwd, 512, LDS_BYTES) != hipSuccess || per_cu < 1) { fprintf(stderr, "kernel_launch: occupancy query gave %d\n", per_cu); per_cu = 1; }
        (void)hipGetLastError();
        grid = cus * per_cu;
        if (grid != 256) { fprintf(stderr, "kernel_launch: this kernel deals one RG-LRU unit per wave of a 256-workgroup grid; got %d x %d\n", cus, per_cu); grid = -1; return; }
    }
    if (grid < 0) return;
    Args a{};
    for (int i = 0; i < 18; ++i) a.in[i] = (const float*)d_in[i];
    a.out = (float*)d_out; a.ws = (unsigned char*)d_ws; a.dup = DUP_MASK;
#if N_LAUNCH_SPLIT
    for (int p = 0; p < N_PHASES; ++p) { a.ph_lo = p; a.ph_hi = p + 1; hipLaunchKernelGGL(hymba_fwd, dim3(grid), dim3(512), LDS_BYTES, stream, a); }
#else
    a.ph_lo = 0; a.ph_hi = N_PHASES;
    if (hipMemsetAsync((char*)d_ws + WS_BAR, 0, XCD_BAR_WORDS * 4, stream) != hipSuccess) { fprintf(stderr, "kernel_launch: hipMemsetAsync of the barrier words failed\n"); return; }
    void* args[] = {&a};
    hipError_t e = hipLaunchCooperativeKernel((const void*)hymba_fwd, dim3(grid), dim3(512), args, LDS_BYTES, stream);
    if (e != hipSuccess) fprintf(stderr, "kernel_launch: cooperative launch failed: %s (grid %d)\n", hipGetErrorString(e), grid);
#endif
}
```
